# Optimizing an MI355X kernel written in HIP

```python
import math
import jax, jax.numpy as jnp
from jax import lax
import numpy as np

D_MODEL = 1024
BATCH = 8
SEQ = 4096
DEPTH = 1

GRID_W = 64
CTX_LEN = 256
HEAD_DIM = 64
NA_HEADS = 8
NA_WIDTH = NA_HEADS * HEAD_DIM
NA_WIN_H = 8
NA_WIN_W = 16
HY_WIDTH = D_MODEL // 2
HY_ORDER = 2
HY_SHORT = 3
HY_EMB = 33
HY_BANDS = (HY_EMB - 1) // 2
HY_FFN = 64
HY_FAST_DECAY = 0.3
HY_SLOW_DECAY = 1.5
HY_TARGET = 1e-2
HY_FILTER_SCALE = 0.008
HY_PROJ = (HY_ORDER + 1) * HY_WIDTH
FFN_HIDDEN = -(-(8 * D_MODEL) // (3 * 256)) * 256
N_MOD = 6
ROPE_THETA = 10000.0
RMS_EPS = 1e-6
NEG_INF = -1e30
IN_SPLITS = (NA_WIDTH, 2 * NA_WIDTH, 3 * NA_WIDTH, 3 * NA_WIDTH + HY_WIDTH,
             3 * NA_WIDTH + 2 * HY_WIDTH, 3 * NA_WIDTH + HY_PROJ, 3 * NA_WIDTH + HY_PROJ + D_MODEL)
IN_WIDTH = 3 * NA_WIDTH + HY_PROJ + 2 * D_MODEL

kernel_name = 'hybrid_na_hyena_dit_block'


def rmsnorm(x, g):
    xf = x.astype(jnp.float32)
    y = xf * lax.rsqrt(jnp.mean(xf * xf, axis=-1, keepdims=True) + RMS_EPS)
    return (y * g.astype(jnp.float32)).astype(x.dtype)


def modulate(h, shift, scale):
    return h * (1 + scale) + shift


def to_heads(a):
    B, L, _ = a.shape
    return a.reshape(B, L, NA_HEADS, HEAD_DIM)


def axial_rope(x, rows, cols):
    nf = HEAD_DIM // 4
    inv = ROPE_THETA ** (-jnp.arange(nf, dtype=jnp.float32) / nf)

    def rot(xp, pos):
        ang = pos.astype(jnp.float32)[:, None] * inv
        cos = jnp.cos(ang)[None, :, None, :]
        sin = jnp.sin(ang)[None, :, None, :]
        x1 = xp[..., :nf].astype(jnp.float32)
        x2 = xp[..., nf:].astype(jnp.float32)
        return jnp.concatenate([x1 * cos - x2 * sin, x2 * cos + x1 * sin], axis=-1)

    half = HEAD_DIM // 2
    return jnp.concatenate([rot(x[..., :half], rows), rot(x[..., half:], cols)], axis=-1).astype(x.dtype)


def neighbourhood_attention(q, k, v, k_ctx, v_ctx, rpb):
    B, L, H, Dh = q.shape
    R = L // GRID_W
    wh = min(NA_WIN_H, R)
    scale = Dh ** -0.5
    t = jnp.arange(L)
    rows, cols = t // GRID_W, t % GRID_W
    q_rot = axial_rope(q, rows, cols)
    k_rot = axial_rope(k, rows, cols)

    def grid(a):
        return a.reshape(B, R, GRID_W, H, Dh)

    r = jnp.arange(R)
    row_idx = jnp.clip(r - wh // 2, 0, R - wh)[:, None] + jnp.arange(wh)[None, :]
    k_band = grid(k_rot)[:, row_idx]
    v_band = grid(v)[:, row_idx]
    cq = jnp.arange(GRID_W)
    start_c = jnp.clip(cq - NA_WIN_W // 2, 0, GRID_W - NA_WIN_W)
    col_ok = (cq[None, :] >= start_c[:, None]) & (cq[None, :] < start_c[:, None] + NA_WIN_W)
    roff = row_idx - r[:, None] + (NA_WIN_H - 1)
    coff = jnp.clip(cq[None, :] - cq[:, None], -(NA_WIN_W - 1), NA_WIN_W - 1) + (NA_WIN_W - 1)
    bias = rpb.astype(jnp.float32)[:, roff[:, None, :, None], coff[None, :, None, :]]
    s_nb = jnp.einsum('brqhd,brikhd->bhrqik', grid(q_rot), k_band,
                      preferred_element_type=jnp.float32) * scale + bias[None]
    s_nb = jnp.where(col_ok[:, None, :], s_nb, NEG_INF)
    s_ctx = jnp.einsum('brqhd,bchd->bhrqc', grid(q), k_ctx, preferred_element_type=jnp.float32) * scale
    s = jnp.concatenate([s_nb.reshape(B, H, R, GRID_W, wh * GRID_W), s_ctx], axis=-1)
    p = jax.nn.softmax(s, axis=-1).astype(v.dtype)
    p_nb = p[..., :wh * GRID_W].reshape(B, H, R, GRID_W, wh, GRID_W)
    p_ctx = p[..., wh * GRID_W:]
    o = (jnp.einsum('bhrqik,brikhd->brqhd', p_nb, v_band)
         + jnp.einsum('bhrqc,bchd->brqhd', p_ctx, v_ctx))
    return o.reshape(B, L, H * Dh)


def context_attention(q, k, v):
    B, Lc, H, Dh = q.shape
    s = jnp.einsum('bqhd,bkhd->bhqk', q, k, preferred_element_type=jnp.float32) * (Dh ** -0.5)
    p = jax.nn.softmax(s, axis=-1).astype(v.dtype)
    return jnp.einsum('bhqk,bkhd->bqhd', p, v).reshape(B, Lc, H * Dh)


def short_conv(u, w, b):
    up = jnp.pad(u, ((0, 0), (1, 1), (0, 0)))
    return up[:, :-2] * w[0] + up[:, 1:-1] * w[1] + up[:, 2:] * w[2] + b


def hyena_filters(L, w1, b1, w2, b2, freq, w3):
    f32 = jnp.float32
    t = jnp.linspace(0.0, 1.0, L, dtype=f32)[:, None]
    w = 2.0 * math.pi * jnp.arange(L, dtype=f32)[:, None] / L
    bands = jnp.linspace(1e-4, HY_BANDS - 1, HY_BANDS, dtype=f32)
    z = jnp.concatenate([t, jnp.cos(bands * w), jnp.sin(-bands * w)], axis=-1)
    fr = freq.astype(f32)
    hid = jnp.sin(fr * (z @ w1.astype(f32) + b1.astype(f32)))
    hid = jnp.sin(fr * (hid @ w2.astype(f32) + b2.astype(f32)))
    h = (hid @ w3.astype(f32)).reshape(L, 2, HY_ORDER, HY_WIDTH)
    min_decay = math.log(HY_TARGET) / HY_SLOW_DECAY
    max_decay = math.log(HY_TARGET) / HY_FAST_DECAY
    deltas = jnp.abs(jnp.linspace(min_decay, max_decay, HY_WIDTH, dtype=f32))
    decay = jnp.exp(-t * deltas)
    return h * decay[:, None, None, :]


def long_conv_bidir(u, h_fwd, h_bwd, bias):
    B, L, C = u.shape
    k2 = jnp.concatenate([h_fwd, jnp.zeros((1, C), jnp.float32), h_bwd[:0:-1]], axis=0)
    U = jnp.fft.rfft(u.astype(jnp.float32), n=2 * L, axis=1)
    K = jnp.fft.rfft(k2, n=2 * L, axis=0)
    y = jnp.fft.irfft(U * K[None], n=2 * L, axis=1)[:, :L]
    return (y + u.astype(jnp.float32) * bias.astype(jnp.float32)).astype(u.dtype)


def hyena_mixer(hv, hx1, hx2, conv_w, conv_b, w1, b1, w2, b2, freq, w3, bias):
    u = short_conv(jnp.concatenate([hv, hx1, hx2], axis=-1), conv_w, conv_b)
    parts = jnp.split(u, HY_ORDER + 1, axis=-1)
    z, gates = parts[0], parts[1:]
    filt = hyena_filters(z.shape[1], w1, b1, w2, b2, freq, w3)
    for n in range(HY_ORDER):
        z = gates[n] * long_conv_bidir(z, filt[:, 0, n], filt[:, 1, n], bias[n])
    return z


def gated_merge(g_na, g_hy, y_na, y_hy, w_na_o, w_hy_o, w_out):
    m = jax.nn.sigmoid(g_na) * (y_na @ w_na_o) + jax.nn.sigmoid(g_hy) * (y_hy @ w_hy_o)
    return m @ w_out


def swiglu(h, w1, w3, w2):
    return (jax.nn.silu(h @ w1) * (h @ w3)) @ w2


def setup_inputs(seed: int = 0) -> dict:
    key = jax.random.key(seed)
    ks = jax.random.split(key, 32)
    f32 = jnp.float32

    def nrm(k, shape, scale):
        return jax.random.normal(k, shape, f32) * scale

    return {
        'x': nrm(ks[0], (BATCH, SEQ, D_MODEL), 1.0),
        'c': nrm(ks[1], (BATCH, D_MODEL), 1.0),
        'ctx': nrm(ks[2], (BATCH, CTX_LEN, D_MODEL), 1.0),
        'c_ctx': nrm(ks[3], (D_MODEL,), 1.0),
        'w_ada': nrm(ks[4], (DEPTH, D_MODEL, N_MOD * D_MODEL), D_MODEL ** -0.5),
        'b_ada': nrm(ks[5], (DEPTH, N_MOD * D_MODEL), 0.02),
        'norm1_g': 1.0 + nrm(ks[6], (DEPTH, D_MODEL), 0.02),
        'norm2_g': 1.0 + nrm(ks[7], (DEPTH, D_MODEL), 0.02),
        'w_in': nrm(ks[8], (DEPTH, D_MODEL, IN_WIDTH), D_MODEL ** -0.5),
        'na_rpb': nrm(ks[9], (DEPTH, NA_HEADS, 2 * NA_WIN_H - 1, 2 * NA_WIN_W - 1), 0.1),
        'hy_conv_w': nrm(ks[10], (DEPTH, HY_SHORT, HY_PROJ), HY_SHORT ** -0.5),
        'hy_conv_b': nrm(ks[11], (DEPTH, HY_PROJ), 0.02),
        'hy_ffn_w1': nrm(ks[12], (DEPTH, HY_EMB, HY_FFN), HY_EMB ** -0.5),
        'hy_ffn_b1': nrm(ks[13], (DEPTH, HY_FFN), 0.1),
        'hy_ffn_w2': nrm(ks[14], (DEPTH, HY_FFN, HY_FFN), HY_FFN ** -0.5),
        'hy_ffn_b2': nrm(ks[15], (DEPTH, HY_FFN), 0.1),
        'hy_sin_freq': 1.0 + nrm(ks[16], (DEPTH, HY_FFN), 0.05),
        'hy_ffn_w3': nrm(ks[17], (DEPTH, HY_FFN, 2 * HY_ORDER * HY_WIDTH), HY_FILTER_SCALE),
        'hy_bias': nrm(ks[18], (DEPTH, HY_ORDER, HY_WIDTH), 0.2),
        'w_na_o': nrm(ks[19], (DEPTH, NA_WIDTH, D_MODEL), NA_WIDTH ** -0.5),
        'w_hy_o': nrm(ks[20], (DEPTH, HY_WIDTH, D_MODEL), HY_WIDTH ** -0.5),
        'w_out': nrm(ks[21], (DEPTH, D_MODEL, D_MODEL), D_MODEL ** -0.5),
        'ffn_w1': nrm(ks[22], (DEPTH, D_MODEL, FFN_HIDDEN), D_MODEL ** -0.5),
        'ffn_w3': nrm(ks[23], (DEPTH, D_MODEL, FFN_HIDDEN), D_MODEL ** -0.5),
        'ffn_w2': nrm(ks[24], (DEPTH, FFN_HIDDEN, D_MODEL), FFN_HIDDEN ** -0.5),
        'final_g': 1.0 + nrm(ks[25], (D_MODEL,), 0.02),
    }


def reference(x, c, ctx, c_ctx, w_ada, b_ada, norm1_g, norm2_g, w_in, na_rpb, hy_conv_w, hy_conv_b,
              hy_ffn_w1, hy_ffn_b1, hy_ffn_w2, hy_ffn_b2, hy_sin_freq, hy_ffn_w3, hy_bias,
              w_na_o, w_hy_o, w_out, ffn_w1, ffn_w3, ffn_w2, final_g):
    xc = ctx
    for i in range(DEPTH):
        last = i == DEPTH - 1
        mod = jax.nn.silu(c) @ w_ada[i] + b_ada[i]
        mod_c = jax.nn.silu(c_ctx) @ w_ada[i] + b_ada[i]
        sh1, sc1, g1, sh2, sc2, g2 = jnp.split(mod[:, None, :], N_MOD, axis=-1)
        csh1, csc1, cg1, csh2, csc2, cg2 = jnp.split(mod_c, N_MOD, axis=-1)
        hy_params = (hy_conv_w[i], hy_conv_b[i], hy_ffn_w1[i], hy_ffn_b1[i], hy_ffn_w2[i], hy_ffn_b2[i],
                     hy_sin_freq[i], hy_ffn_w3[i], hy_bias[i])

        hc = modulate(rmsnorm(xc, norm1_g[i]), csh1, csc1)
        if last:
            k_c, v_c = jnp.split(hc @ w_in[i][:, NA_WIDTH:3 * NA_WIDTH], 2, axis=-1)
        else:
            q_c, k_c, v_c, hv_c, hx1_c, hx2_c, gna_c, ghy_c = jnp.split(hc @ w_in[i], IN_SPLITS, axis=-1)
            y_na_c = context_attention(to_heads(q_c), to_heads(k_c), to_heads(v_c))
            y_hy_c = hyena_mixer(hv_c, hx1_c, hx2_c, *hy_params)
            xc_next = xc + cg1 * gated_merge(gna_c, ghy_c, y_na_c, y_hy_c, w_na_o[i], w_hy_o[i], w_out[i])
            hc2 = modulate(rmsnorm(xc_next, norm2_g[i]), csh2, csc2)
            xc_next = xc_next + cg2 * swiglu(hc2, ffn_w1[i], ffn_w3[i], ffn_w2[i])

        h = modulate(rmsnorm(x, norm1_g[i]), sh1, sc1)
        q, k, v, hv, hx1, hx2, gna, ghy = jnp.split(h @ w_in[i], IN_SPLITS, axis=-1)
        y_na = neighbourhood_attention(to_heads(q), to_heads(k), to_heads(v),
                                       to_heads(k_c), to_heads(v_c), na_rpb[i])
        y_hy = hyena_mixer(hv, hx1, hx2, *hy_params)
        x = x + g1 * gated_merge(gna, ghy, y_na, y_hy, w_na_o[i], w_hy_o[i], w_out[i])
        h2 = modulate(rmsnorm(x, norm2_g[i]), sh2, sc2)
        x = x + g2 * swiglu(h2, ffn_w1[i], ffn_w3[i], ffn_w2[i])
        if not last:
            xc = xc_next
    return rmsnorm(x, final_g)
```

```cpp
#include <hip/hip_runtime.h>
#include <hip/hip_cooperative_groups.h>
#include <cstdio>
#include <cstdint>
namespace cg = cooperative_groups;
namespace pg8 {
#define PG8_LAS __attribute__((address_space(3)))
typedef unsigned short bf16_t;
typedef short bf16x8 __attribute__((ext_vector_type(8)));
typedef float f32x4 __attribute__((ext_vector_type(4)));
typedef unsigned u32x4 __attribute__((ext_vector_type(4)));
constexpr int BM = 256, BK = 64, HALF = 128, HTB = HALF * BK * 2  , STAGE_BYTES = 8 * HTB, NXCD = 8, WGM = 8;

__host__ __device__ __forceinline__ int lds_byte(int r, int c) { const int st = (r >> 4) * 2 + (c >> 5), rr = r & 15, cc = c & 31, ob = rr * 64 + cc * 2; return st * 1024 + (ob ^ (((ob >> 9) & 1) << 5)); }
__host__ __device__ __forceinline__ void stage_rc(int b, int& R, int& C) { const int st = b / 1024, sb = b % 1024, swz = sb ^ (((sb >> 9) & 1) << 5); R = (st >> 1) * 16 + swz / 64; C = (st & 1) * 32 + (swz % 64) / 2; }
__host__ __device__ __forceinline__ int perm32(int rho) { const int n = rho >> 4, i = rho & 15; return 8 * (i >> 2) + 4 * n + (i & 3); }

struct Unit { int pm, pn; };
struct Gemm { const bf16_t* A; const bf16_t* Bt; int M, N, K; };

struct StaticOrder {
    int nM, nN, nwg, G, c;
    __host__ __device__ void init(int M, int N, int G_, int c_) { nM = M / BM; nN = N / BM; nwg = nM * nN; G = G_; c = c_; }
    __host__ __device__ bool next(int i, Unit& u) const {
        const long L = (long)i * G + c; if (L >= nwg) return false;
        int wgid = (int)L; { const int q = nwg / NXCD, r = nwg % NXCD, xcd = wgid % NXCD, off = wgid / NXCD; wgid = (xcd < r ? xcd * (q + 1) : r * (q + 1) + (xcd - r) * q) + off; }
        const int nig = WGM * nN, gid = wgid / nig, fm = gid * WGM, gsz = (nM - fm) < WGM ? (nM - fm) : WGM;
        u.pm = fm + ((wgid % nig) % gsz); u.pn = (wgid % nig) / gsz; return true;
    }
    __device__ __forceinline__ void a_ready(const Unit&) const {}
    __device__ __forceinline__ void done(const Unit&) const {}
};

__device__ __forceinline__ unsigned cvt_pk_bf16(float lo, float hi) { unsigned r; asm volatile("v_cvt_pk_bf16_f32 %0, %1, %2" : "=v"(r) : "v"(lo), "v"(hi)); return r; }
template <class Epi, class Sched, bool ALIGN_EPI = false, bool SP2 = false>
__device__ __forceinline__ void gemm_phase(PG8_LAS unsigned char* lds, const Gemm g, const Sched& S, const Epi& E) {
    const int tid = threadIdx.x, wid = __builtin_amdgcn_readfirstlane(tid >> 6), lane = tid & 63, wr = wid >> 2, wc = wid & 3, fr = lane & 15, fq = lane >> 4;
    const int K = g.K, nt = K / BK;
    unsigned voffA[2], voffB[2];
#pragma unroll
    for (int i = 0; i < 2; ++i) { int R, C; stage_rc(tid * 16 + i * 8192, R, C); const int Rb = Epi::PERM ? ((R & ~31) + perm32(R & 31)) : R;
        voffA[i] = (unsigned)(R * K + C) * 2u; voffB[i] = (unsigned)(Rb * K + C) * 2u; }
    const size_t kstep = (size_t)(BK * 2);
    const size_t hstep = (size_t)HALF * K * 2;
    const size_t tstep = 2 * hstep;
    const unsigned ldsw = (unsigned)wid * 1024u;
    const int aoff = lds_byte(wr * 64 + fr, fq * 8), boff = lds_byte(wc * 32 + fr, fq * 8);
#define PG8_SA(b, h) (((b) * 2 + (h)) * HTB)
#define PG8_SB(b, h) ((4 + (b) * 2 + (h)) * HTB)
#define PG8_STAGE(bufoff, gbase, voff) do { _Pragma("unroll") for (int _i = 0; _i < 2; ++_i) \
        __builtin_amdgcn_global_load_lds((const unsigned*)((const char*)(gbase) + (voff)[_i]), (PG8_LAS unsigned*)(lds + (bufoff) + ldsw + _i * 8192), 16, 0, 0); } while (0)
#define PG8_LDA(dst, b, h) do { _Pragma("unroll") for (int m = 0; m < 4; ++m) _Pragma("unroll") for (int k = 0; k < 2; ++k) dst[m][k] = *(const PG8_LAS bf16x8*)(lds + PG8_SA(b, h) + aoff + m * 2048 + k * 1024); } while (0)
#define PG8_LDB(dst, b, h) do { _Pragma("unroll") for (int n = 0; n < 2; ++n) _Pragma("unroll") for (int k = 0; k < 2; ++k) dst[n][k] = *(const PG8_LAS bf16x8*)(lds + PG8_SB(b, h) + boff + n * 2048 + k * 1024); } while (0)
#define PG8_MMA(ai, bj, At, Bt) do { __builtin_amdgcn_s_setprio(1); _Pragma("unroll") for (int m = 0; m < 4; ++m) _Pragma("unroll") for (int n = 0; n < 2; ++n) _Pragma("unroll") for (int k = 0; k < 2; ++k) \
        acc[ai][bj][m][n] = __builtin_amdgcn_mfma_f32_16x16x32_bf16(Bt[n][k], At[m][k], acc[ai][bj][m][n], 0, 0, 0); __builtin_amdgcn_s_setprio(0); } while (0)
#define PG8_WAIT_V(n) asm volatile("s_waitcnt vmcnt(" #n ")" ::: "memory")
#define PG8_WAIT_L(n) asm volatile("s_waitcnt lgkmcnt(" #n ")" ::: "memory")
#define PG8_BAR __builtin_amdgcn_s_barrier()
#define PG8_SCHED __builtin_amdgcn_sched_barrier(0)
    Unit cur, nxt; int ui = 0;
    if (!S.next(0, cur)) return;
    f32x4 acc[2][2][4][2];
#pragma unroll
    for (int a = 0; a < 2; ++a)
#pragma unroll
        for (int b = 0; b < 2; ++b)
#pragma unroll
            for (int m = 0; m < 4; ++m)
#pragma unroll
                for (int n = 0; n < 2; ++n) acc[a][b][m][n] = (f32x4){0.f, 0.f, 0.f, 0.f};
    bf16x8 At[4][2], B0[2][2], B1[2][2];
    const char* cA = (const char*)g.A + (size_t)cur.pm * tstep; const char* cB = (const char*)g.Bt + (size_t)cur.pn * tstep;
    S.a_ready(cur);
    if constexpr (SP2) {
        PG8_STAGE(PG8_SB(0, 0), cB, voffB); PG8_STAGE(PG8_SB(0, 1), cB + hstep, voffB); PG8_STAGE(PG8_SA(0, 0), cA, voffA); PG8_STAGE(PG8_SA(0, 1), cA + hstep, voffA);
        if (wr == 1) PG8_BAR;
        PG8_WAIT_V(2); PG8_BAR;
        PG8_STAGE(PG8_SB(1, 0), cB + kstep, voffB); PG8_STAGE(PG8_SA(1, 0), cA + kstep, voffA); PG8_STAGE(PG8_SB(1, 1), cB + hstep + kstep, voffB);
        PG8_WAIT_V(6); PG8_BAR;
    } else {
        PG8_STAGE(PG8_SB(0, 0), cB, voffB); PG8_STAGE(PG8_SA(0, 0), cA, voffA); PG8_STAGE(PG8_SB(0, 1), cB + hstep, voffB); PG8_STAGE(PG8_SA(0, 1), cA + hstep, voffA);
        if (wr == 1) PG8_BAR;
        PG8_WAIT_V(4); PG8_BAR;
        PG8_STAGE(PG8_SB(1, 0), cB + kstep, voffB); PG8_STAGE(PG8_SA(1, 0), cA + kstep, voffA); PG8_STAGE(PG8_SB(1, 1), cB + hstep + kstep, voffB);
        PG8_WAIT_V(6); PG8_BAR;
    }
    for (;;) {
        const bool has_next = S.next(ui + 1, nxt);
        const char* nA = has_next ? (const char*)g.A + (size_t)nxt.pm * tstep : cA; const char* nB = has_next ? (const char*)g.Bt + (size_t)nxt.pn * tstep : cB;
        for (int t = 0; t < nt; t += 2) {
            const bool last = (t == nt - 2);
            const char* a1 = cA + (size_t)(t + 1) * kstep;
            const char* a2 = last ? nA : cA + (size_t)(t + 2) * kstep; const char* b2 = last ? nB : cB + (size_t)(t + 2) * kstep;
            const char* a3 = a2 + kstep; const char* b3 = b2 + kstep;
            if (last && has_next) S.a_ready(nxt);
            if constexpr (SP2) {
            PG8_LDB(B0, 0, 0); PG8_LDB(B1, 0, 1); PG8_SCHED; PG8_LDA(At, 0, 0); PG8_STAGE(PG8_SA(1, 1), a1 + hstep, voffA);
            PG8_WAIT_V(8); PG8_WAIT_L(0); PG8_BAR; PG8_MMA(0, 0, At, B0); PG8_MMA(0, 1, At, B1); PG8_BAR; PG8_SCHED;
            PG8_LDA(At, 0, 1); PG8_STAGE(PG8_SB(0, 0), b2, voffB); PG8_STAGE(PG8_SB(0, 1), b2 + hstep, voffB); PG8_STAGE(PG8_SA(0, 0), a2, voffA);
            PG8_WAIT_V(8); PG8_WAIT_L(0); PG8_BAR; PG8_MMA(1, 0, At, B0); PG8_MMA(1, 1, At, B1); PG8_BAR; PG8_SCHED;
            PG8_LDB(B0, 1, 0); PG8_LDB(B1, 1, 1); PG8_SCHED; PG8_LDA(At, 1, 0); PG8_STAGE(PG8_SA(0, 1), a2 + hstep, voffA);
            PG8_WAIT_V(8); PG8_WAIT_L(0); PG8_BAR; PG8_MMA(0, 0, At, B0); PG8_MMA(0, 1, At, B1); PG8_BAR; PG8_SCHED;
            PG8_LDA(At, 1, 1); PG8_STAGE(PG8_SB(1, 0), b3, voffB); PG8_STAGE(PG8_SB(1, 1), b3 + hstep, voffB); PG8_STAGE(PG8_SA(1, 0), a3, voffA);
            PG8_WAIT_V(8); PG8_WAIT_L(0); PG8_BAR; PG8_MMA(1, 0, At, B0); PG8_MMA(1, 1, At, B1); PG8_BAR; PG8_SCHED;
            } else {
            PG8_LDB(B0, 0, 0); PG8_SCHED; PG8_LDA(At, 0, 0); PG8_STAGE(PG8_SA(1, 1), a1 + hstep, voffA);
            PG8_WAIT_L(8); PG8_BAR; PG8_WAIT_L(0); PG8_MMA(0, 0, At, B0); PG8_BAR; PG8_SCHED;
            PG8_LDB(B1, 0, 1); PG8_STAGE(PG8_SB(0, 0), b2, voffB);
            PG8_BAR; PG8_WAIT_L(0); PG8_MMA(0, 1, At, B1); PG8_BAR;
            PG8_LDA(At, 0, 1); PG8_STAGE(PG8_SA(0, 0), a2, voffA);
            PG8_BAR; PG8_WAIT_L(0); PG8_MMA(1, 0, At, B0); PG8_BAR; PG8_SCHED;
            PG8_STAGE(PG8_SB(0, 1), b2 + hstep, voffB);
            PG8_WAIT_V(6); PG8_BAR; PG8_MMA(1, 1, At, B1); PG8_BAR;
            PG8_LDB(B0, 1, 0); PG8_SCHED; PG8_LDA(At, 1, 0); PG8_STAGE(PG8_SA(0, 1), a2 + hstep, voffA);
            PG8_WAIT_L(8); PG8_BAR; PG8_WAIT_L(0); PG8_MMA(0, 0, At, B0); PG8_BAR; PG8_SCHED;
            PG8_LDB(B1, 1, 1); PG8_STAGE(PG8_SB(1, 0), b3, voffB);
            PG8_BAR; PG8_WAIT_L(0); PG8_MMA(0, 1, At, B1); PG8_BAR;
            PG8_LDA(At, 1, 1); PG8_STAGE(PG8_SA(1, 0), a3, voffA);
            PG8_BAR; PG8_WAIT_L(0); PG8_MMA(1, 0, At, B0); PG8_BAR; PG8_SCHED;
            PG8_STAGE(PG8_SB(1, 1), b3 + hstep, voffB);
            PG8_WAIT_V(6); PG8_BAR; PG8_MMA(1, 1, At, B1); PG8_BAR;
            }
        }
        if constexpr (ALIGN_EPI) { if (wr == 0) PG8_BAR; }
        if constexpr (!Epi::AFTER_DRAIN) { E(acc, cur, wr, wc, fr, fq); S.done(cur); }
        if (!has_next) break;
#pragma unroll
        for (int a = 0; a < 2; ++a)
#pragma unroll
            for (int b = 0; b < 2; ++b)
#pragma unroll
                for (int m = 0; m < 4; ++m)
#pragma unroll
                    for (int n = 0; n < 2; ++n) acc[a][b][m][n] = (f32x4){0.f, 0.f, 0.f, 0.f};
        cur = nxt; cA = nA; cB = nB; ++ui;
        if constexpr (ALIGN_EPI) { if (wr == 1) PG8_BAR; }
    }
    PG8_WAIT_V(0);
    if constexpr (!ALIGN_EPI) { if (wr == 0) PG8_BAR; }
    PG8_BAR;
    if constexpr (Epi::AFTER_DRAIN) { E.fused(acc, cur, wr, wc, fr, fq, lds, wid, lane); S.done(cur); }
#undef PG8_SA
#undef PG8_SB
#undef PG8_STAGE
#undef PG8_LDA
#undef PG8_LDB
#undef PG8_MMA
#undef PG8_WAIT_V
#undef PG8_WAIT_L
#undef PG8_BAR
#undef PG8_SCHED
}
template <class Epi, class Sched, bool ALIGN_EPI = false, bool SP2 = false>
__device__ __forceinline__ void gemm_phase_dual(PG8_LAS unsigned char* lds, const Gemm g, const Gemm g1, const Sched& S, const Epi& E) {
    const int tid = threadIdx.x, wid = __builtin_amdgcn_readfirstlane(tid >> 6), lane = tid & 63, wr = wid >> 2, wc = wid & 3, fr = lane & 15, fq = lane >> 4;
    const int K = g.K, nt = K / BK;
    unsigned voffA[2], voffB[2];
#pragma unroll
    for (int i = 0; i < 2; ++i) { int R, C; stage_rc(tid * 16 + i * 8192, R, C); const int Rb = Epi::PERM ? ((R & ~31) + perm32(R & 31)) : R;
        voffA[i] = (unsigned)(R * K + C) * 2u; voffB[i] = (unsigned)(Rb * K + C) * 2u; }
    const size_t kstep = (size_t)(BK * 2);
    const size_t hstep = (size_t)HALF * K * 2;
    const size_t tstep = 2 * hstep;
    const unsigned ldsw = (unsigned)wid * 1024u;
    const int aoff = lds_byte(wr * 64 + fr, fq * 8), boff = lds_byte(wc * 32 + fr, fq * 8);
#define PG8_SA(b, h) (((b) * 2 + (h)) * HTB)
#define PG8_SB(b, h) ((4 + (b) * 2 + (h)) * HTB)
#define PG8_STAGE(bufoff, gbase, voff) do { _Pragma("unroll") for (int _i = 0; _i < 2; ++_i) \
        __builtin_amdgcn_global_load_lds((const unsigned*)((const char*)(gbase) + (voff)[_i]), (PG8_LAS unsigned*)(lds + (bufoff) + ldsw + _i * 8192), 16, 0, 0); } while (0)
#define PG8_LDA(dst, b, h) do { _Pragma("unroll") for (int m = 0; m < 4; ++m) _Pragma("unroll") for (int k = 0; k < 2; ++k) dst[m][k] = *(const PG8_LAS bf16x8*)(lds + PG8_SA(b, h) + aoff + m * 2048 + k * 1024); } while (0)
#define PG8_LDB(dst, b, h) do { _Pragma("unroll") for (int n = 0; n < 2; ++n) _Pragma("unroll") for (int k = 0; k < 2; ++k) dst[n][k] = *(const PG8_LAS bf16x8*)(lds + PG8_SB(b, h) + boff + n * 2048 + k * 1024); } while (0)
#define PG8_MMA(ai, bj, At, Bt) do { __builtin_amdgcn_s_setprio(1); _Pragma("unroll") for (int m = 0; m < 4; ++m) _Pragma("unroll") for (int n = 0; n < 2; ++n) _Pragma("unroll") for (int k = 0; k < 2; ++k) \
        acc[ai][bj][m][n] = __builtin_amdgcn_mfma_f32_16x16x32_bf16(Bt[n][k], At[m][k], acc[ai][bj][m][n], 0, 0, 0); __builtin_amdgcn_s_setprio(0); } while (0)
#define PG8_WAIT_V(n) asm volatile("s_waitcnt vmcnt(" #n ")" ::: "memory")
#define PG8_WAIT_L(n) asm volatile("s_waitcnt lgkmcnt(" #n ")" ::: "memory")
#define PG8_BAR __builtin_amdgcn_s_barrier()
#define PG8_SCHED __builtin_amdgcn_sched_barrier(0)
    Unit cur, nxt; int ui = 0;
    if (!S.next(0, cur)) return;
    f32x4 acc[2][2][4][2];
#pragma unroll
    for (int a = 0; a < 2; ++a)
#pragma unroll
        for (int b = 0; b < 2; ++b)
#pragma unroll
            for (int m = 0; m < 4; ++m)
#pragma unroll
                for (int n = 0; n < 2; ++n) acc[a][b][m][n] = (f32x4){0.f, 0.f, 0.f, 0.f};
    bf16x8 At[4][2], B0[2][2], B1[2][2];
    const char* cA = (const char*)((cur.pn >> 16) ? g1.A : g.A) + (size_t)cur.pm * tstep; const char* cB = (const char*)((cur.pn >> 16) ? g1.Bt : g.Bt) + (size_t)(cur.pn & 0xffff) * tstep;
    S.a_ready(cur);
    if constexpr (SP2) {
        PG8_STAGE(PG8_SB(0, 0), cB, voffB); PG8_STAGE(PG8_SB(0, 1), cB + hstep, voffB); PG8_STAGE(PG8_SA(0, 0), cA, voffA); PG8_STAGE(PG8_SA(0, 1), cA + hstep, voffA);
        if (wr == 1) PG8_BAR;
        PG8_WAIT_V(2); PG8_BAR;
        PG8_STAGE(PG8_SB(1, 0), cB + kstep, voffB); PG8_STAGE(PG8_SA(1, 0), cA + kstep, voffA); PG8_STAGE(PG8_SB(1, 1), cB + hstep + kstep, voffB);
        PG8_WAIT_V(6); PG8_BAR;
    } else {
        PG8_STAGE(PG8_SB(0, 0), cB, voffB); PG8_STAGE(PG8_SA(0, 0), cA, voffA); PG8_STAGE(PG8_SB(0, 1), cB + hstep, voffB); PG8_STAGE(PG8_SA(0, 1), cA + hstep, voffA);
        if (wr == 1) PG8_BAR;
        PG8_WAIT_V(4); PG8_BAR;
        PG8_STAGE(PG8_SB(1, 0), cB + kstep, voffB); PG8_STAGE(PG8_SA(1, 0), cA + kstep, voffA); PG8_STAGE(PG8_SB(1, 1), cB + hstep + kstep, voffB);
        PG8_WAIT_V(6); PG8_BAR;
    }
    for (;;) {
        const bool has_next = S.next(ui + 1, nxt);
        const char* nA = has_next ? (const char*)((nxt.pn >> 16) ? g1.A : g.A) + (size_t)nxt.pm * tstep : cA; const char* nB = has_next ? (const char*)((nxt.pn >> 16) ? g1.Bt : g.Bt) + (size_t)(nxt.pn & 0xffff) * tstep : cB;
        for (int t = 0; t < nt; t += 2) {
            const bool last = (t == nt - 2);
            const char* a1 = cA + (size_t)(t + 1) * kstep;
            const char* a2 = last ? nA : cA + (size_t)(t + 2) * kstep; const char* b2 = last ? nB : cB + (size_t)(t + 2) * kstep;
            const char* a3 = a2 + kstep; const char* b3 = b2 + kstep;
            if (last && has_next) S.a_ready(nxt);
            if constexpr (SP2) {
            PG8_LDB(B0, 0, 0); PG8_LDB(B1, 0, 1); PG8_SCHED; PG8_LDA(At, 0, 0); PG8_STAGE(PG8_SA(1, 1), a1 + hstep, voffA);
            PG8_WAIT_V(8); PG8_WAIT_L(0); PG8_BAR; PG8_MMA(0, 0, At, B0); PG8_MMA(0, 1, At, B1); PG8_BAR; PG8_SCHED;
            PG8_LDA(At, 0, 1); PG8_STAGE(PG8_SB(0, 0), b2, voffB); PG8_STAGE(PG8_SB(0, 1), b2 + hstep, voffB); PG8_STAGE(PG8_SA(0, 0), a2, voffA);
            PG8_WAIT_V(8); PG8_WAIT_L(0); PG8_BAR; PG8_MMA(1, 0, At, B0); PG8_MMA(1, 1, At, B1); PG8_BAR; PG8_SCHED;
            PG8_LDB(B0, 1, 0); PG8_LDB(B1, 1, 1); PG8_SCHED; PG8_LDA(At, 1, 0); PG8_STAGE(PG8_SA(0, 1), a2 + hstep, voffA);
            PG8_WAIT_V(8); PG8_WAIT_L(0); PG8_BAR; PG8_MMA(0, 0, At, B0); PG8_MMA(0, 1, At, B1); PG8_BAR; PG8_SCHED;
            PG8_LDA(At, 1, 1); PG8_STAGE(PG8_SB(1, 0), b3, voffB); PG8_STAGE(PG8_SB(1, 1), b3 + hstep, voffB); PG8_STAGE(PG8_SA(1, 0), a3, voffA);
            PG8_WAIT_V(8); PG8_WAIT_L(0); PG8_BAR; PG8_MMA(1, 0, At, B0); PG8_MMA(1, 1, At, B1); PG8_BAR; PG8_SCHED;
            } else {
            PG8_LDB(B0, 0, 0); PG8_SCHED; PG8_LDA(At, 0, 0); PG8_STAGE(PG8_SA(1, 1), a1 + hstep, voffA);
            PG8_WAIT_L(8); PG8_BAR; PG8_WAIT_L(0); PG8_MMA(0, 0, At, B0); PG8_BAR; PG8_SCHED;
            PG8_LDB(B1, 0, 1); PG8_STAGE(PG8_SB(0, 0), b2, voffB);
            PG8_BAR; PG8_WAIT_L(0); PG8_MMA(0, 1, At, B1); PG8_BAR;
            PG8_LDA(At, 0, 1); PG8_STAGE(PG8_SA(0, 0), a2, voffA);
            PG8_BAR; PG8_WAIT_L(0); PG8_MMA(1, 0, At, B0); PG8_BAR; PG8_SCHED;
            PG8_STAGE(PG8_SB(0, 1), b2 + hstep, voffB);
            PG8_WAIT_V(6); PG8_BAR; PG8_MMA(1, 1, At, B1); PG8_BAR;
            PG8_LDB(B0, 1, 0); PG8_SCHED; PG8_LDA(At, 1, 0); PG8_STAGE(PG8_SA(0, 1), a2 + hstep, voffA);
            PG8_WAIT_L(8); PG8_BAR; PG8_WAIT_L(0); PG8_MMA(0, 0, At, B0); PG8_BAR; PG8_SCHED;
            PG8_LDB(B1, 1, 1); PG8_STAGE(PG8_SB(1, 0), b3, voffB);
            PG8_BAR; PG8_WAIT_L(0); PG8_MMA(0, 1, At, B1); PG8_BAR;
            PG8_LDA(At, 1, 1); PG8_STAGE(PG8_SA(1, 0), a3, voffA);
            PG8_BAR; PG8_WAIT_L(0); PG8_MMA(1, 0, At, B0); PG8_BAR; PG8_SCHED;
            PG8_STAGE(PG8_SB(1, 1), b3 + hstep, voffB);
            PG8_WAIT_V(6); PG8_BAR; PG8_MMA(1, 1, At, B1); PG8_BAR;
            }
        }
        if constexpr (ALIGN_EPI) { if (wr == 0) PG8_BAR; }
        if constexpr (!Epi::AFTER_DRAIN) { E(acc, cur, wr, wc, fr, fq); S.done(cur); }
        if (!has_next) break;
        if (cur.pn >> 16)
#pragma unroll
        for (int a = 0; a < 2; ++a)
#pragma unroll
            for (int b = 0; b < 2; ++b)
#pragma unroll
                for (int m = 0; m < 4; ++m)
#pragma unroll
                    for (int n = 0; n < 2; ++n) acc[a][b][m][n] = (f32x4){0.f, 0.f, 0.f, 0.f};
        cur = nxt; cA = nA; cB = nB; ++ui;
        if constexpr (ALIGN_EPI) { if (wr == 1) PG8_BAR; }
    }
    PG8_WAIT_V(0);
    if constexpr (!ALIGN_EPI) { if (wr == 0) PG8_BAR; }
    PG8_BAR;
    if constexpr (Epi::AFTER_DRAIN) { E.fused(acc, cur, wr, wc, fr, fq, lds, wid, lane); S.done(cur); }
#undef PG8_SA
#undef PG8_SB
#undef PG8_STAGE
#undef PG8_LDA
#undef PG8_LDB
#undef PG8_MMA
#undef PG8_WAIT_V
#undef PG8_WAIT_L
#undef PG8_BAR
#undef PG8_SCHED
}
}

namespace ep {
using pg8::f32x4; using pg8::u32x4; using pg8::Unit; using pg8::bf16_t; using pg8::BM; using pg8::HALF; using pg8::cvt_pk_bf16;
typedef float f32x2 __attribute__((ext_vector_type(2)));
__device__ __forceinline__ float bf_lo(unsigned w) { return __uint_as_float(w << 16); }
__device__ __forceinline__ float bf_hi(unsigned w) { return __uint_as_float(w & 0xffff0000u); }
__device__ __forceinline__ float sigm(float x) { return __builtin_amdgcn_rcpf(1.0f + __expf(-x)); }
#define EP_ACC const f32x4 (&acc)[2][2][4][2], const Unit& u, int wr, int wc, int fr, int fq

struct EpiPlain { static constexpr bool PERM = true, AFTER_DRAIN = false; bf16_t* O; int ldc;
    __device__ __forceinline__ void operator()(EP_ACC) const {
        const int row0 = u.pm * BM + wr * 64 + fr, col0 = u.pn * BM + wc * 32 + 8 * fq;
#pragma unroll
        for (int ai = 0; ai < 2; ++ai)
#pragma unroll
            for (int m = 0; m < 4; ++m) { bf16_t* rowp = O + (size_t)(row0 + ai * HALF + m * 16) * ldc + col0;
#pragma unroll
                for (int bj = 0; bj < 2; ++bj) { const f32x4 v0 = acc[ai][bj][m][0], v1 = acc[ai][bj][m][1];
                    u32x4 w; w.x = cvt_pk_bf16(v0[0], v0[1]); w.y = cvt_pk_bf16(v0[2], v0[3]); w.z = cvt_pk_bf16(v1[0], v1[1]); w.w = cvt_pk_bf16(v1[2], v1[3]);
                    *(u32x4*)(rowp + bj * HALF) = w; } }
    }
};
struct EpiQKG { static constexpr bool PERM = true, AFTER_DRAIN = false; bf16_t* O; const f32x2* rope;
    __device__ __forceinline__ void operator()(EP_ACC) const {
        const int row0 = u.pm * BM + wr * 64 + fr, col0 = u.pn * BM + wc * 32 + 8 * fq;
        const bool isk = (u.pn == 2) || (u.pn == 3);
        const int jg = (wc & 1) * 4 + fq, i0 = (jg & 3) * 4;
#pragma unroll
        for (int ai = 0; ai < 2; ++ai)
#pragma unroll
            for (int m = 0; m < 4; ++m) { const int row = row0 + ai * HALF + m * 16; bf16_t* rowp = O + (size_t)row * 3072 + col0;
                const int t = row & 4095, pos = (jg & 4) ? (t & 63) : (t >> 6);
                f32x2 cs[4];
                if (isk) {
#pragma unroll
                    for (int e = 0; e < 4; ++e) cs[e] = rope[pos * 16 + i0 + e];
                }
#pragma unroll
                for (int bj = 0; bj < 2; ++bj) { f32x4 v0 = acc[ai][bj][m][0], v1 = acc[ai][bj][m][1];
                    if (isk) {
#pragma unroll
                        for (int e = 0; e < 4; ++e) { const float x1 = v0[e], x2 = v1[e]; v0[e] = x1 * cs[e].x - x2 * cs[e].y; v1[e] = x2 * cs[e].x + x1 * cs[e].y; }
                    }
                    u32x4 w; w.x = cvt_pk_bf16(v0[0], v0[1]); w.y = cvt_pk_bf16(v0[2], v0[3]); w.z = cvt_pk_bf16(v1[0], v1[1]); w.w = cvt_pk_bf16(v1[2], v1[3]);
                    *(u32x4*)(rowp + bj * HALF) = w; } }
    }
};
struct EpiGateNA { static constexpr bool PERM = true, AFTER_DRAIN = false; float* M1; const bf16_t* G;
    __device__ __forceinline__ void operator()(EP_ACC) const {
        const int row0 = u.pm * BM + wr * 64 + fr, col0 = u.pn * BM + wc * 32 + 8 * fq;
#pragma unroll
        for (int ai = 0; ai < 2; ++ai)
#pragma unroll
            for (int m = 0; m < 4; ++m) { const size_t row = (size_t)(row0 + ai * HALF + m * 16);
#pragma unroll
                for (int bj = 0; bj < 2; ++bj) { const int col = col0 + bj * HALF; const f32x4 v0 = acc[ai][bj][m][0], v1 = acc[ai][bj][m][1];
                    const u32x4 gw = *(const u32x4*)(G + row * 3072 + 1024 + col);
                    f32x4 o0, o1;
                    o0[0] = sigm(bf_lo(gw.x)) * v0[0]; o0[1] = sigm(bf_hi(gw.x)) * v0[1]; o0[2] = sigm(bf_lo(gw.y)) * v0[2]; o0[3] = sigm(bf_hi(gw.y)) * v0[3];
                    o1[0] = sigm(bf_lo(gw.z)) * v1[0]; o1[1] = sigm(bf_hi(gw.z)) * v1[1]; o1[2] = sigm(bf_lo(gw.w)) * v1[2]; o1[3] = sigm(bf_hi(gw.w)) * v1[3];
                    float* op = M1 + row * 1024 + col; *(f32x4*)op = o0; *(f32x4*)(op + 4) = o1; } }
    }
};
struct EpiGateHY { static constexpr bool PERM = true, AFTER_DRAIN = false; const float* M1; const bf16_t* G; bf16_t* MB;
    __device__ __forceinline__ void operator()(EP_ACC) const {
        const int row0 = u.pm * BM + wr * 64 + fr, col0 = u.pn * BM + wc * 32 + 8 * fq;
#pragma unroll
        for (int ai = 0; ai < 2; ++ai)
#pragma unroll
            for (int m = 0; m < 4; ++m) { const size_t row = (size_t)(row0 + ai * HALF + m * 16);
#pragma unroll
                for (int bj = 0; bj < 2; ++bj) { const int col = col0 + bj * HALF; const f32x4 v0 = acc[ai][bj][m][0], v1 = acc[ai][bj][m][1];
                    const u32x4 gw = *(const u32x4*)(G + row * 3072 + 2048 + col);
                    const float* ip = M1 + row * 1024 + col; const f32x4 a0 = *(const f32x4*)ip, a1 = *(const f32x4*)(ip + 4);
                    f32x4 o0, o1;
                    o0[0] = a0[0] + sigm(bf_lo(gw.x)) * v0[0]; o0[1] = a0[1] + sigm(bf_hi(gw.x)) * v0[1]; o0[2] = a0[2] + sigm(bf_lo(gw.y)) * v0[2]; o0[3] = a0[3] + sigm(bf_hi(gw.y)) * v0[3];
                    o1[0] = a1[0] + sigm(bf_lo(gw.z)) * v1[0]; o1[1] = a1[1] + sigm(bf_hi(gw.z)) * v1[1]; o1[2] = a1[2] + sigm(bf_lo(gw.w)) * v1[2]; o1[3] = a1[3] + sigm(bf_hi(gw.w)) * v1[3];
                    u32x4 w; w.x = cvt_pk_bf16(o0[0], o0[1]); w.y = cvt_pk_bf16(o0[2], o0[3]); w.z = cvt_pk_bf16(o1[0], o1[1]); w.w = cvt_pk_bf16(o1[2], o1[3]);
                    *(u32x4*)(MB + row * 1024 + col) = w; } }
    }
};
struct EpiRes1 { static constexpr bool PERM = true, AFTER_DRAIN = false; const float* x; bf16_t* X1B; const float* mod; const float* n2g; bf16_t* A2; unsigned long long* rowss;
    __device__ __forceinline__ void operator()(EP_ACC) const {
        const int row0 = u.pm * BM + wr * 64 + fr, col0 = u.pn * BM + wc * 32 + 8 * fq;
        const float* mb = mod + (size_t)((u.pm * BM) >> 12) * 6144;
        float ss[2][4];
#pragma unroll
        for (int ai = 0; ai < 2; ++ai)
#pragma unroll
            for (int m = 0; m < 4; ++m) ss[ai][m] = 0.f;
#pragma unroll
        for (int bj = 0; bj < 2; ++bj) { const int col = col0 + bj * HALF;
            const f32x4 gv0 = *(const f32x4*)(mb + 2048 + col), gv1 = *(const f32x4*)(mb + 2048 + col + 4);
            const f32x4 gs0 = *(const f32x4*)(n2g + col) * (*(const f32x4*)(mb + 4096 + col) + 1.0f), gs1 = *(const f32x4*)(n2g + col + 4) * (*(const f32x4*)(mb + 4096 + col + 4) + 1.0f);
#pragma unroll
            for (int ai = 0; ai < 2; ++ai)
#pragma unroll
                for (int m = 0; m < 4; ++m) { const size_t off = (size_t)(row0 + ai * HALF + m * 16) * 1024 + col;
                    const f32x4 a0 = __builtin_nontemporal_load((const f32x4*)(x + off)) + gv0 * acc[ai][bj][m][0], a1 = __builtin_nontemporal_load((const f32x4*)(x + off + 4)) + gv1 * acc[ai][bj][m][1];
                    { u32x4 wx; wx.x = cvt_pk_bf16(a0[0], a0[1]); wx.y = cvt_pk_bf16(a0[2], a0[3]); wx.z = cvt_pk_bf16(a1[0], a1[1]); wx.w = cvt_pk_bf16(a1[2], a1[3]); *(u32x4*)(X1B + off) = wx; }
                    ss[ai][m] += ((a0[0] * a0[0] + a0[1] * a0[1]) + (a0[2] * a0[2] + a0[3] * a0[3])) + ((a1[0] * a1[0] + a1[1] * a1[1]) + (a1[2] * a1[2] + a1[3] * a1[3]));
                    const f32x4 s0 = a0 * gs0, s1 = a1 * gs1;
                    u32x4 w; w.x = cvt_pk_bf16(s0[0], s0[1]); w.y = cvt_pk_bf16(s0[2], s0[3]); w.z = cvt_pk_bf16(s1[0], s1[1]); w.w = cvt_pk_bf16(s1[2], s1[3]);
                    *(u32x4*)(A2 + off) = w; } }
#pragma unroll
        for (int ai = 0; ai < 2; ++ai)
#pragma unroll
            for (int m = 0; m < 4; ++m) { float t = ss[ai][m]; t += __shfl_xor(t, 16); t += __shfl_xor(t, 32);
                if (fq == 0) atomicAdd(rowss + row0 + ai * HALF + m * 16, (unsigned long long)(t * 1048576.0f + 0.5f)); }
    }
};
struct EpiRes2 { static constexpr bool PERM = true, AFTER_DRAIN = false; float* out; const float* mod; unsigned long long* rowss; const bf16_t* X1B;
    __device__ __forceinline__ void operator()(EP_ACC) const {
        const int row0 = u.pm * BM + wr * 64 + fr, col0 = u.pn * BM + wc * 32 + 8 * fq;
        const float* mb = mod + (size_t)((u.pm * BM) >> 12) * 6144;
        float ss[2][4];
#pragma unroll
        for (int ai = 0; ai < 2; ++ai)
#pragma unroll
            for (int m = 0; m < 4; ++m) ss[ai][m] = 0.f;
#pragma unroll
        for (int bj = 0; bj < 2; ++bj) { const int col = col0 + bj * HALF;
            const f32x4 gv0 = *(const f32x4*)(mb + 5120 + col), gv1 = *(const f32x4*)(mb + 5120 + col + 4);
#pragma unroll
            for (int ai = 0; ai < 2; ++ai)
#pragma unroll
                for (int m = 0; m < 4; ++m) { const size_t off = (size_t)(row0 + ai * HALF + m * 16) * 1024 + col;
                    const u32x4 xb = __builtin_nontemporal_load((const u32x4*)(X1B + off));
                    f32x4 x0, x1; x0[0] = bf_lo(xb.x); x0[1] = bf_hi(xb.x); x0[2] = bf_lo(xb.y); x0[3] = bf_hi(xb.y); x1[0] = bf_lo(xb.z); x1[1] = bf_hi(xb.z); x1[2] = bf_lo(xb.w); x1[3] = bf_hi(xb.w);
                    const f32x4 a0 = x0 + gv0 * acc[ai][bj][m][0], a1 = x1 + gv1 * acc[ai][bj][m][1];
                    *(f32x4*)(out + off) = a0; *(f32x4*)(out + off + 4) = a1;
                    ss[ai][m] += ((a0[0] * a0[0] + a0[1] * a0[1]) + (a0[2] * a0[2] + a0[3] * a0[3])) + ((a1[0] * a1[0] + a1[1] * a1[1]) + (a1[2] * a1[2] + a1[3] * a1[3])); } }
#pragma unroll
        for (int ai = 0; ai < 2; ++ai)
#pragma unroll
            for (int m = 0; m < 4; ++m) { float t = ss[ai][m]; t += __shfl_xor(t, 16); t += __shfl_xor(t, 32);
                if (fq == 0) atomicAdd(rowss + row0 + ai * HALF + m * 16, (unsigned long long)(t * 1048576.0f + 0.5f)); }
    }
};
struct EpiFFN { static constexpr bool PERM = true, AFTER_DRAIN = false; bf16_t* HID; const unsigned long long* rowss; const float* sW;
    __device__ __forceinline__ void operator()(EP_ACC) const {
        const int row0 = u.pm * BM + wr * 64 + fr, col0 = u.pn * HALF + wc * 32 + 8 * fq;
        const float* sp = sW + (size_t)((u.pm * BM) >> 12) * 5632 + u.pn * BM + wc * 32 + 8 * fq;
        const f32x4 s1a = *(const f32x4*)sp, s1b = *(const f32x4*)(sp + 4), s3a = *(const f32x4*)(sp + HALF), s3b = *(const f32x4*)(sp + HALF + 4);
#pragma unroll
        for (int ai = 0; ai < 2; ++ai)
#pragma unroll
            for (int m = 0; m < 4; ++m) { const int row = row0 + ai * HALF + m * 16; bf16_t* rowp = HID + (size_t)row * 2816 + col0;
                const float rstd = __builtin_amdgcn_rsqf((float)rowss[row] * (1.0f / (1024.0f * 1048576.0f)) + 1e-6f);
                const f32x4 a0 = acc[ai][0][m][0] * rstd + s1a, a1 = acc[ai][0][m][1] * rstd + s1b, b0 = acc[ai][1][m][0] * rstd + s3a, b1 = acc[ai][1][m][1] * rstd + s3b;
                f32x4 o0, o1;
#pragma unroll
                for (int e = 0; e < 4; ++e) { o0[e] = a0[e] * sigm(a0[e]) * b0[e]; o1[e] = a1[e] * sigm(a1[e]) * b1[e]; }
                u32x4 w; w.x = cvt_pk_bf16(o0[0], o0[1]); w.y = cvt_pk_bf16(o0[2], o0[3]); w.z = cvt_pk_bf16(o1[0], o1[1]); w.w = cvt_pk_bf16(o1[2], o1[3]);
                *(u32x4*)rowp = w; }
    }
};
struct EpiGateDual { static constexpr bool PERM = true, AFTER_DRAIN = false; const bf16_t* G; bf16_t* MB;
    __device__ __forceinline__ void operator()(f32x4 (&acc)[2][2][4][2], const Unit& u, int wr, int wc, int fr, int fq) const {
        const int part = u.pn >> 16, pn = u.pn & 0xffff;
        const int row0 = u.pm * BM + wr * 64 + fr, col0 = pn * BM + wc * 32 + 8 * fq;
#pragma unroll
        for (int ai = 0; ai < 2; ++ai)
#pragma unroll
            for (int m = 0; m < 4; ++m) { const size_t row = (size_t)(row0 + ai * HALF + m * 16);
#pragma unroll
                for (int bj = 0; bj < 2; ++bj) { const int col = col0 + bj * HALF;
                    const u32x4 gh = *(const u32x4*)(G + row * 3072 + 2048 + col);
                    if (part == 0) { const u32x4 gn = __builtin_nontemporal_load((const u32x4*)(G + row * 3072 + 1024 + col));
                        f32x4 r0, r1;
                        r0[0] = (1.0f + __expf(-bf_lo(gh.x))) * __builtin_amdgcn_rcpf(1.0f + __expf(-bf_lo(gn.x))); r0[1] = (1.0f + __expf(-bf_hi(gh.x))) * __builtin_amdgcn_rcpf(1.0f + __expf(-bf_hi(gn.x)));
                        r0[2] = (1.0f + __expf(-bf_lo(gh.y))) * __builtin_amdgcn_rcpf(1.0f + __expf(-bf_lo(gn.y))); r0[3] = (1.0f + __expf(-bf_hi(gh.y))) * __builtin_amdgcn_rcpf(1.0f + __expf(-bf_hi(gn.y)));
                        r1[0] = (1.0f + __expf(-bf_lo(gh.z))) * __builtin_amdgcn_rcpf(1.0f + __expf(-bf_lo(gn.z))); r1[1] = (1.0f + __expf(-bf_hi(gh.z))) * __builtin_amdgcn_rcpf(1.0f + __expf(-bf_hi(gn.z)));
                        r1[2] = (1.0f + __expf(-bf_lo(gh.w))) * __builtin_amdgcn_rcpf(1.0f + __expf(-bf_lo(gn.w))); r1[3] = (1.0f + __expf(-bf_hi(gh.w))) * __builtin_amdgcn_rcpf(1.0f + __expf(-bf_hi(gn.w)));
                        acc[ai][bj][m][0] = acc[ai][bj][m][0] * r0; acc[ai][bj][m][1] = acc[ai][bj][m][1] * r1; }
                    else { const f32x4 v0 = acc[ai][bj][m][0], v1 = acc[ai][bj][m][1];
                        u32x4 w; w.x = cvt_pk_bf16(sigm(bf_lo(gh.x)) * v0[0], sigm(bf_hi(gh.x)) * v0[1]); w.y = cvt_pk_bf16(sigm(bf_lo(gh.y)) * v0[2], sigm(bf_hi(gh.y)) * v0[3]);
                        w.z = cvt_pk_bf16(sigm(bf_lo(gh.z)) * v1[0], sigm(bf_hi(gh.z)) * v1[1]); w.w = cvt_pk_bf16(sigm(bf_lo(gh.w)) * v1[2], sigm(bf_hi(gh.w)) * v1[3]);
                        *(u32x4*)(MB + row * 1024 + col) = w; } } }
    }
};
struct DualOrder { pg8::StaticOrder b;
    __device__ bool next(int i, Unit& u) const { if (!b.next(i >> 1, u)) return false; u.pn |= (i & 1) << 16; return true; }
    __device__ __forceinline__ void a_ready(const Unit&) const {}
    __device__ __forceinline__ void done(const Unit&) const {}
};
#undef EP_ACC
}

#define LAS __attribute__((address_space(3)))
typedef unsigned short bf16;
typedef short bf16x8 __attribute__((ext_vector_type(8)));
typedef short s16x4 __attribute__((ext_vector_type(4)));
typedef float f32x4 __attribute__((ext_vector_type(4)));
typedef float f32x2 __attribute__((ext_vector_type(2)));
typedef unsigned u32x4 __attribute__((ext_vector_type(4)));
typedef unsigned u32x2 __attribute__((ext_vector_type(2)));
constexpr int NW = 8, NT = 512;
constexpr int DM = 1024, MTOK = 32768, MCTX = 2048, MALL = MTOK + MCTX, FF = 2816, NMOD = 6144;
constexpr size_t MiB = (size_t)1 << 20;
constexpr size_t WS_WIN = 0, WS_WNAO = 10 * MiB, WS_WHYO = 11 * MiB, WS_WOUT = 12 * MiB, WS_W13 = 14 * MiB, WS_W2 = 25 * MiB;
constexpr size_t WS_MOD = 30 * MiB + 512 * 1024, WS_ROPE = 30 * MiB + 768 * 1024, WS_HID2 = 31 * MiB;
constexpr size_t WS_K2 = 32 * MiB;
constexpr size_t WS_H = 64 * MiB;
constexpr size_t WS_QKG = 132 * MiB;
constexpr size_t WS_YHT = 324 * MiB;
constexpr size_t WS_MB = 356 * MiB;
constexpr size_t WS_KC = 420 * MiB, WS_VCT = 422 * MiB;
constexpr size_t WS_Z1T = 424 * MiB;
constexpr size_t WS_RSS2 = 488 * MiB, WS_RSS3 = 488 * MiB + 256 * 1024;
constexpr size_t WS_SW = 488 * MiB + 512 * 1024;
constexpr size_t WS_CTL = 488 * MiB + 768 * 1024; constexpr int CTL_BYTES = 16384;
constexpr size_t WS_END = 489 * MiB;
constexpr int MISC_OFF = 2 * 8704 * 8;
constexpr int LDS_BYTES = 2 * 8704 * 8 + 1024;

#define XB_TMO      128
#define XB_XCNT(j)  (256  + 64 * (j))
#define XB_XSUB(j)  (1280 + 64 * (j))
#define XB_XGEN(j)  (2304 + 64 * (j))
#define XB_TOP      3328
#define XB_TOPGEN   3392
#define XCD_BAR_WORDS 3456
#define XB_SPIN_CAP (1u << 18)

__device__ __forceinline__ unsigned xb_ld(unsigned* p)              { return __hip_atomic_load(p, __ATOMIC_RELAXED, __HIP_MEMORY_SCOPE_AGENT); }
__device__ __forceinline__ unsigned xb_add(unsigned* p, unsigned v) { return __hip_atomic_fetch_add(p, v, __ATOMIC_RELAXED, __HIP_MEMORY_SCOPE_AGENT); }
__device__ __forceinline__ unsigned xb_xcc_id() { return (unsigned)__builtin_amdgcn_s_getreg((3 << 11) | 20) & 0xFu; }
#define XB_SPIN(cond, bar) do { unsigned _sp = 0; while (cond) { __builtin_amdgcn_s_sleep(1); \
    if ((++_sp & 255u) == 0u) { if (xb_ld(&(bar)[XB_TMO])) break; if (_sp > XB_SPIN_CAP) { atomicAdd(&(bar)[XB_TMO], 1u); break; } } } } while (0)

struct XcdBarrier {
    unsigned* bar; unsigned x;
    volatile LAS unsigned* st;
};

__device__ __forceinline__ XcdBarrier xcd_barrier_post(unsigned* bar, volatile LAS unsigned* st) {
    XcdBarrier b; b.bar = bar; b.x = xb_xcc_id(); b.st = st;
    if (threadIdx.x == 0) (void)xb_add(&bar[XB_XCNT(b.x)], 1u);
    return b;
}
__device__ __forceinline__ void xcd_barrier_complete(unsigned* bar, unsigned x, unsigned& nloc, unsigned& nx) {
    const unsigned G = gridDim.x * gridDim.y * gridDim.z;
    unsigned sum, cnt, mine, sp = 0u;
    for (;;) {
        sum = 0u; cnt = 0u; mine = 0u;
#pragma unroll
        for (unsigned j = 0; j < 16; ++j) { const unsigned c = xb_ld(&bar[XB_XCNT(j)]); sum += c; cnt += (c > 0u) ? 1u : 0u; mine = (j == x) ? c : mine; }
        if (sum == G) break;
        __builtin_amdgcn_s_sleep(1);
        if ((++sp & 255u) == 0u) { if (xb_ld(&bar[XB_TMO])) break; if (sp > XB_SPIN_CAP) { atomicAdd(&bar[XB_TMO], 1u); break; } }
    }
    nloc = mine > 0u ? mine : 1u; nx = cnt > 0u ? cnt : 1u;
}

__device__ __forceinline__ void xcd_barrier(const XcdBarrier& b) {
    asm volatile("s_waitcnt vmcnt(0)" ::: "memory");
    __syncthreads();
    if (threadIdx.x == 0) {
        unsigned* bar = b.bar;
        __builtin_amdgcn_s_waitcnt(0);
        unsigned nloc = b.st[0], nx = b.st[1];
        if (nloc == 0u) { xcd_barrier_complete(bar, b.x, nloc, nx); b.st[0] = nloc; b.st[1] = nx; }
        const unsigned old = xb_add(&bar[XB_XSUB(b.x)], 1u);
        const unsigned gen = old / nloc;
        if (old + 1u == (gen + 1u) * nloc) {
            __builtin_amdgcn_fence(__ATOMIC_RELEASE, "agent");
            asm volatile("s_waitcnt vmcnt(0)" ::: "memory");
            const unsigned og = xb_add(&bar[XB_TOP], 1u);
            const unsigned tg = og / nx;
            if (og + 1u == (tg + 1u) * nx) xb_add(&bar[XB_TOPGEN], 1u);
            else XB_SPIN(xb_ld(&bar[XB_TOPGEN]) == tg, bar);
            __builtin_amdgcn_fence(__ATOMIC_ACQUIRE, "agent");
            xb_add(&bar[XB_XGEN(b.x)], 1u);
            asm volatile("s_waitcnt vmcnt(0)" ::: "memory");
        } else {
            XB_SPIN(xb_ld(&bar[XB_XGEN(b.x)]) == gen, bar);
            __builtin_amdgcn_fence(__ATOMIC_ACQUIRE, "agent");
            asm volatile("s_waitcnt vmcnt(0)" ::: "memory");
        }
    }
    __syncthreads();
}

#define LDS_WAIT() asm volatile("s_waitcnt lgkmcnt(0)" ::: "memory")
__device__ __forceinline__ unsigned f2bf(float f) { unsigned u = __builtin_bit_cast(unsigned, f); return (u + 0x7fffu + ((u >> 16) & 1u)) >> 16; }
__device__ __forceinline__ unsigned pk2(float lo, float hi) { return f2bf(lo) | (f2bf(hi) << 16); }
__device__ __forceinline__ float bf2f(unsigned short s) { return __uint_as_float(((unsigned)s) << 16); }
__device__ __forceinline__ float wave_sum(float v) {
#pragma unroll
    for (int o = 1; o < 64; o <<= 1) v += __shfl_xor(v, o);
    return v;
}

__device__ __forceinline__ void tr_item(const float* W, int ldw, int srccol, bf16* WT, int K, int n0, int k0, LAS float* scr, int lane) {
    float tmp[32];
#pragma unroll
    for (int i = 0; i < 32; ++i) tmp[i] = __builtin_nontemporal_load(W + (size_t)(k0 + 2 * i + (lane >> 5)) * ldw + srccol);
#pragma unroll
    for (int i = 0; i < 32; ++i) scr[(2 * i + (lane >> 5)) * 33 + (lane & 31)] = tmp[i];
    LDS_WAIT(); asm volatile("" ::: "memory");
    const int c = lane & 7;
#pragma unroll
    for (int j = 0; j < 4; ++j) { const int n = (lane >> 3) + 8 * j; const LAS float* s = scr + (8 * c) * 33 + n;
        u32x4 o; o.x = pk2(s[0 * 33], s[1 * 33]); o.y = pk2(s[2 * 33], s[3 * 33]); o.z = pk2(s[4 * 33], s[5 * 33]); o.w = pk2(s[6 * 33], s[7 * 33]);
        *(u32x4*)(WT + (size_t)(n0 + n) * K + k0 + 8 * c) = o; }
    LDS_WAIT(); asm volatile("" ::: "memory");
}
__device__ __forceinline__ int mapcol_in(int n) {
    if (n < 1024) { const int base = n & 512, r = n & 511, h = r >> 6, s = r & 63, jg = s >> 3, e = s & 7;
        const int bs = (jg < 4) ? 4 * jg : 32 + 4 * (jg - 4); return base + h * 64 + bs + ((e < 4) ? e : 12 + e); }
    if (n < 3072) return 3072 + (n - 1024);
    return 1024 + (n - 3072);
}
__device__ __forceinline__ void norm_row(const float* xrow, bf16* orow, const float* g, const float* sh, const float* sc, int lane) {
    f32x4 v[4]; float s = 0.f;
#pragma unroll
    for (int j = 0; j < 4; ++j) { v[j] = *((const f32x4*)xrow + lane + 64 * j); s += (v[j].x * v[j].x + v[j].y * v[j].y) + (v[j].z * v[j].z + v[j].w * v[j].w); }
    const float rstd = 1.0f / sqrtf(wave_sum(s) * (1.f / 1024.f) + 1e-6f);
#pragma unroll
    for (int j = 0; j < 4; ++j) { const int k = 4 * (lane + 64 * j);
        const f32x4 gg = *(const f32x4*)(g + k), hh = *(const f32x4*)(sh + k), cc = *(const f32x4*)(sc + k);
        const f32x4 y = v[j] * rstd * gg * (cc + 1.0f) + hh;
        u32x2 w; w.x = pk2(y.x, y.y); w.y = pk2(y.z, y.w); *(u32x2*)(orow + k) = w; }
}

constexpr int XPAD = 8704;
__device__ __forceinline__ f32x2 cmul(f32x2 a, f32x2 b) { f32x2 ax = {a.x, a.x}, ay = {a.y, a.y}, bq = {-b.y, b.x}; return ax * b + ay * bq; }
__device__ __forceinline__ f32x2 cmulc(f32x2 a, f32x2 b) { f32x2 ax = {a.x, a.x}, ay = {a.y, a.y}, bc = {b.x, -b.y}, bq = {b.y, b.x}; return ax * bc + ay * bq; }
__device__ __forceinline__ f32x2 cmul_bf(f32x2 a, f32x2 b) { f32x2 t, r;
    asm("v_pk_mul_f32 %0, %1, %2 op_sel:[0,0] op_sel_hi:[0,1]" : "=v"(t) : "v"(a), "v"(b));
    asm("v_pk_fma_f32 %0, %1, %2, %3 op_sel:[1,1,0] op_sel_hi:[1,0,1] neg_lo:[0,1,0]" : "=v"(r) : "v"(a), "v"(b), "v"(t));
    return r; }
__device__ __forceinline__ f32x2 cmulc_bf(f32x2 a, f32x2 b) { f32x2 t, r;
    asm("v_pk_mul_f32 %0, %1, %2 op_sel:[0,0] op_sel_hi:[0,1] neg_hi:[0,1]" : "=v"(t) : "v"(a), "v"(b));
    asm("v_pk_fma_f32 %0, %1, %2, %3 op_sel:[1,1,0] op_sel_hi:[1,0,1]" : "=v"(r) : "v"(a), "v"(b), "v"(t));
    return r; }
struct Tw { f32x2 t1[8], t2[4], t3[2], t4; };
template <bool ZERO> __device__ __forceinline__ void mk_tw(Tw& T, float theta  ) {
    const float C16C[8] = {1.000000000f, 0.923879533f, 0.707106781f, 0.382683432f, 0.000000000f, -0.382683432f, -0.707106781f, -0.923879533f};
    const float C16S[8] = {0.000000000f, -0.382683432f, -0.707106781f, -0.923879533f, -1.000000000f, -0.923879533f, -0.707106781f, -0.382683432f};
    f32x2 W1; if (ZERO) { W1.x = 1.f; W1.y = 0.f; } else { W1.x = __builtin_amdgcn_cosf(theta); W1.y = -__builtin_amdgcn_sinf(theta); }
    const f32x2 W2 = cmul(W1, W1), W4 = cmul(W2, W2), W8 = cmul(W4, W4);
#pragma unroll
    for (int m = 0; m < 8; ++m) { f32x2 c; c.x = C16C[m]; c.y = C16S[m]; T.t1[m] = cmul(W1, c); }
#pragma unroll
    for (int m = 0; m < 4; ++m) { f32x2 c; c.x = C16C[2 * m]; c.y = C16S[2 * m]; T.t2[m] = cmul(W2, c); }
    T.t3[0] = W4; T.t3[1].x = W4.y; T.t3[1].y = -W4.x;
    T.t4 = W8;
}
__device__ __forceinline__ void r16_dif(f32x2 (&v)[16], const Tw& T) {
#pragma unroll
    for (int m = 0; m < 8; ++m) { const f32x2 a = v[m], b = v[m + 8]; v[m] = a + b; v[m + 8] = cmul_bf(a - b, T.t1[m]); }
#pragma unroll
    for (int blk = 0; blk < 16; blk += 8)
#pragma unroll
        for (int m = 0; m < 4; ++m) { const f32x2 a = v[blk + m], b = v[blk + m + 4]; v[blk + m] = a + b; v[blk + m + 4] = cmul_bf(a - b, T.t2[m]); }
#pragma unroll
    for (int blk = 0; blk < 16; blk += 4)
#pragma unroll
        for (int m = 0; m < 2; ++m) { const f32x2 a = v[blk + m], b = v[blk + m + 2]; v[blk + m] = a + b; v[blk + m + 2] = cmul_bf(a - b, T.t3[m]); }
#pragma unroll
    for (int q = 0; q < 16; q += 2) { const f32x2 a = v[q], b = v[q + 1]; v[q] = a + b; v[q + 1] = cmul_bf(a - b, T.t4); }
}
__device__ __forceinline__ void r16_dit(f32x2 (&v)[16], const Tw& T) {
#pragma unroll
    for (int q = 0; q < 16; q += 2) { const f32x2 a = v[q], b = cmulc_bf(v[q + 1], T.t4); v[q] = a + b; v[q + 1] = a - b; }
#pragma unroll
    for (int blk = 0; blk < 16; blk += 4)
#pragma unroll
        for (int m = 0; m < 2; ++m) { const f32x2 a = v[blk + m], b = cmulc_bf(v[blk + m + 2], T.t3[m]); v[blk + m] = a + b; v[blk + m + 2] = a - b; }
#pragma unroll
    for (int blk = 0; blk < 16; blk += 8)
#pragma unroll
        for (int m = 0; m < 4; ++m) { const f32x2 a = v[blk + m], b = cmulc_bf(v[blk + m + 4], T.t2[m]); v[blk + m] = a + b; v[blk + m + 4] = a - b; }
#pragma unroll
    for (int m = 0; m < 8; ++m) { const f32x2 a = v[m], b = cmulc_bf(v[m + 8], T.t1[m]); v[m] = a + b; v[m + 8] = a - b; }
}
__device__ __forceinline__ f32x2 mul_mi(f32x2 d) { f32x2 r; r.x = d.y; r.y = -d.x; return r; }
__device__ __forceinline__ f32x2 mul_pi(f32x2 d) { f32x2 r; r.x = -d.y; r.y = d.x; return r; }
__device__ __forceinline__ f32x2 c16(int m) {
    const float C16C[8] = {1.000000000f, 0.923879533f, 0.707106781f, 0.382683432f, 0.000000000f, -0.382683432f, -0.707106781f, -0.923879533f};
    const float C16S[8] = {0.000000000f, -0.382683432f, -0.707106781f, -0.923879533f, -1.000000000f, -0.923879533f, -0.707106781f, -0.382683432f};
    f32x2 c; c.x = C16C[m]; c.y = C16S[m]; return c;
}
__device__ __forceinline__ void r16_dif0(f32x2 (&v)[16]) {
#pragma unroll
    for (int m = 0; m < 8; ++m) { const f32x2 a = v[m], b = v[m + 8], d = a - b; v[m] = a + b; v[m + 8] = (m == 0) ? d : (m == 4) ? mul_mi(d) : cmul_bf(d, c16(m)); }
#pragma unroll
    for (int blk = 0; blk < 16; blk += 8)
#pragma unroll
        for (int m = 0; m < 4; ++m) { const f32x2 a = v[blk + m], b = v[blk + m + 4], d = a - b; v[blk + m] = a + b; v[blk + m + 4] = (m == 0) ? d : (m == 2) ? mul_mi(d) : cmul_bf(d, c16(2 * m)); }
#pragma unroll
    for (int blk = 0; blk < 16; blk += 4)
#pragma unroll
        for (int m = 0; m < 2; ++m) { const f32x2 a = v[blk + m], b = v[blk + m + 2], d = a - b; v[blk + m] = a + b; v[blk + m + 2] = (m == 0) ? d : mul_mi(d); }
#pragma unroll
    for (int q = 0; q < 16; q += 2) { const f32x2 a = v[q], b = v[q + 1]; v[q] = a + b; v[q + 1] = a - b; }
}
__device__ __forceinline__ void r16_dit0(f32x2 (&v)[16]) {
#pragma unroll
    for (int q = 0; q < 16; q += 2) { const f32x2 a = v[q], b = v[q + 1]; v[q] = a + b; v[q + 1] = a - b; }
#pragma unroll
    for (int blk = 0; blk < 16; blk += 4)
#pragma unroll
        for (int m = 0; m < 2; ++m) { const f32x2 a = v[blk + m], b = (m == 0) ? v[blk + m + 2] : mul_pi(v[blk + m + 2]); v[blk + m] = a + b; v[blk + m + 2] = a - b; }
#pragma unroll
    for (int blk = 0; blk < 16; blk += 8)
#pragma unroll
        for (int m = 0; m < 4; ++m) { const f32x2 a = v[blk + m], x = v[blk + m + 4], b = (m == 0) ? x : (m == 2) ? mul_pi(x) : cmulc_bf(x, c16(2 * m)); v[blk + m] = a + b; v[blk + m + 4] = a - b; }
#pragma unroll
    for (int m = 0; m < 8; ++m) { const f32x2 a = v[m], x = v[m + 8], b = (m == 0) ? x : (m == 4) ? mul_pi(x) : cmulc_bf(x, c16(m)); v[m] = a + b; v[m + 8] = a - b; }
}
__device__ __forceinline__ f32x2 ec32(f32x2 E, int k) {
    const float C32C[16] = {1.000000000f, 0.980785280f, 0.923879533f, 0.831469612f, 0.707106781f, 0.555570233f, 0.382683432f, 0.195090322f, 0.000000000f, -0.195090322f, -0.382683432f, -0.555570233f, -0.707106781f, -0.831469612f, -0.923879533f, -0.980785280f};
    const float C32S[16] = {0.000000000f, -0.195090322f, -0.382683432f, -0.555570233f, -0.707106781f, -0.831469612f, -0.923879533f, -0.980785280f, -1.000000000f, -0.980785280f, -0.923879533f, -0.831469612f, -0.707106781f, -0.555570233f, -0.382683432f, -0.195090322f};
    f32x2 c; c.x = C32C[k]; c.y = C32S[k]; return cmul(E, c);
}
__device__ __forceinline__ f32x2 tw8(f32x2 E0, int e) {
    const float D8C[8] = {1.0000000000f, 0.9999997059f, 0.9999988235f, 0.9999973528f, 0.9999952938f, 0.9999926466f, 0.9999894111f, 0.9999855873f};
    const float D8S[8] = {0.0000000000f, -0.0007669903f, -0.0015339802f, -0.0023009692f, -0.0030679568f, -0.0038349426f, -0.0046019261f, -0.0053689070f};
    f32x2 d; d.x = D8C[e]; d.y = D8S[e]; return cmul(E0, d);
}
__device__ __forceinline__ void sconv8(const float (&raw)[10], float w0, float w1, float w2, float bb, float (&o)[8]) {
#pragma unroll
    for (int e = 0; e < 8; ++e) o[e] = w0 * raw[e] + w1 * raw[e + 1] + w2 * raw[e + 2] + bb;
}
__device__ __forceinline__ void unpack8(u32x4 w, unsigned short l, unsigned short r, bool hasl, bool hasr, float (&raw)[10]) {
    raw[0] = hasl ? bf2f(l) : 0.f; raw[9] = hasr ? bf2f(r) : 0.f;
    raw[1] = __uint_as_float(w.x << 16); raw[2] = __uint_as_float(w.x & 0xffff0000u); raw[3] = __uint_as_float(w.y << 16); raw[4] = __uint_as_float(w.y & 0xffff0000u);
    raw[5] = __uint_as_float(w.z << 16); raw[6] = __uint_as_float(w.z & 0xffff0000u); raw[7] = __uint_as_float(w.w << 16); raw[8] = __uint_as_float(w.w & 0xffff0000u);
}

#define MFMA16(a, b, c) __builtin_amdgcn_mfma_f32_16x16x32_bf16((a), (b), (c), 0, 0, 0)
constexpr int ATT_KC_STRIDE = 72, ATT_VC_STRIDE = 264;
constexpr int ATT_KC_OFF = 0, ATT_VC_OFF = 256 * 72 * 2, ATT_RPB_OFF = ATT_VC_OFF + 64 * 264 * 2;
__device__ __forceinline__ bf16x8 cat8(s16x4 lo, s16x4 hi) { bf16x8 r; r[0] = lo[0]; r[1] = lo[1]; r[2] = lo[2]; r[3] = lo[3]; r[4] = hi[0]; r[5] = hi[1]; r[6] = hi[2]; r[7] = hi[3]; return r; }
template <int NTL> __device__ __forceinline__ void sm_step(f32x4 (&S)[4], float& m_run, float& l_run, float& alpha, bf16x8& pf0, bf16x8& pf1) {
    float mloc = -1e30f;
#pragma unroll
    for (int ct = 0; ct < NTL; ++ct)
#pragma unroll
        for (int j = 0; j < 4; ++j) mloc = fmaxf(mloc, S[ct][j]);
    mloc = fmaxf(mloc, __shfl_xor(mloc, 16)); mloc = fmaxf(mloc, __shfl_xor(mloc, 32));
    const float m_new = fmaxf(m_run, mloc); alpha = __builtin_amdgcn_exp2f(m_run - m_new); m_run = m_new;
    float psum = 0.f;
#pragma unroll
    for (int ct = 0; ct < NTL; ++ct)
#pragma unroll
        for (int j = 0; j < 4; ++j) { const float p = __builtin_amdgcn_exp2f(S[ct][j] - m_new); psum += p; S[ct][j] = p; }
    l_run = l_run * alpha + psum;
#pragma unroll
    for (int j = 0; j < 4; ++j) { pf0[j] = (short)f2bf(S[0][j]); pf0[4 + j] = (short)f2bf(S[1][j]); pf1[j] = (short)f2bf(S[2][j]); pf1[4 + j] = (NTL == 4) ? (short)f2bf(S[3][j]) : (short)0; }
}
template <bool ROT> __device__ __forceinline__ void q_frags(const bf16* qp, const f32x2* rope, int r, int c, int g, bf16x8& q0, bf16x8& q1) {
    const float QS = 0.125f * 1.4426950408889634f;
    const bf16x8 qa = *(const bf16x8*)qp, qb = *(const bf16x8*)(qp + 32);
#pragma unroll
    for (int e = 0; e < 4; ++e) {
        const float x1 = bf2f((unsigned short)qa[e]) * QS, x2 = bf2f((unsigned short)qa[4 + e]) * QS, y1 = bf2f((unsigned short)qb[e]) * QS, y2 = bf2f((unsigned short)qb[4 + e]) * QS;
        if (ROT) { const f32x2 ca = rope[r * 16 + 4 * g + e], cb = rope[c * 16 + 4 * g + e];
            q0[e] = (short)f2bf(x1 * ca.x - x2 * ca.y); q0[4 + e] = (short)f2bf(x2 * ca.x + x1 * ca.y); q1[e] = (short)f2bf(y1 * cb.x - y2 * cb.y); q1[4 + e] = (short)f2bf(y2 * cb.x + y1 * cb.y); }
        else { q0[e] = (short)f2bf(x1); q0[4 + e] = (short)f2bf(x2); q1[e] = (short)f2bf(y1); q1[4 + e] = (short)f2bf(y2); } }
}
__device__ __forceinline__ unsigned bias_idx(int t, int ct0, int g, int c, int sc0) {
    unsigned r = 0u;
#pragma unroll
    for (int j = 0; j < 4; ++j) { const int kc = 16 * (ct0 + t) + 4 * g + j; const bool valid = (kc >= sc0) && (kc < sc0 + 16);
        const int dc = min(max(kc - c, -15), 15) + 15; r |= (unsigned)(valid ? dc : 31) << (8 * j); }
    return r;
}
__device__ __forceinline__ void bias_mask(f32x4 (&S)[4], const LAS float* bp, const unsigned (&idx)[3]) {
#pragma unroll
    for (int t = 0; t < 3; ++t)
#pragma unroll
        for (int j = 0; j < 4; ++j) S[t][j] += bp[(idx[t] >> (8 * j)) & 0xffu];
}
__device__ __forceinline__ void attn_task32(const bf16* QKG, const bf16* VHT, LAS unsigned char* lds, const f32x2* rope, bf16* YNA, int b, int h, int r, int half, int lane) {
    const int lq = lane & 15, g = lane >> 4, cA = 32 * half + lq, cB = cA + 16, ct0 = half;
    const size_t rowA = (size_t)b * 4096 + r * 64 + cA;
    const LAS bf16* KC_L = (const LAS bf16*)(lds + ATT_KC_OFF); const LAS bf16* VC_L = (const LAS bf16*)(lds + ATT_VC_OFF); const LAS float* RPB_L = (const LAS float*)(lds + ATT_RPB_OFF);
    bf16x8 qA0r, qA1r, qB0r, qB1r;
    q_frags<true>(QKG + rowA * 3072 + h * 64 + 8 * g, rope, r, cA, g, qA0r, qA1r);
    q_frags<true>(QKG + (rowA + 16) * 3072 + h * 64 + 8 * g, rope, r, cB, g, qB0r, qB1r);
    const int scA = min(max(cA - 8, 0), 48), scB = min(max(cB - 8, 0), 48), rs = min(max(r - 4, 0), 56);
    unsigned ixA[3], ixB[3];
#pragma unroll
    for (int t = 0; t < 3; ++t) { ixA[t] = bias_idx(t, ct0, g, cA, scA); ixB[t] = bias_idx(t, ct0, g, cB, scB); }
    float mA = -1e30f, lA = 0.f, mB = -1e30f, lB = 0.f;
    f32x4 OA[4], OB[4];
#pragma unroll
    for (int dt = 0; dt < 4; ++dt) { OA[dt] = (f32x4){0.f, 0.f, 0.f, 0.f}; OB[dt] = (f32x4){0.f, 0.f, 0.f, 0.f}; }
    const f32x4 zero4 = {0.f, 0.f, 0.f, 0.f};
    const bf16* kb = QKG + ((size_t)b * 4096 + rs * 64 + 16 * ct0 + lq) * 3072 + 512 + h * 64 + 8 * g;
    const bf16* vb = VHT + (size_t)(h * 64 + lq) * 32768 + (size_t)b * 4096 + rs * 64 + 16 * ct0 + 4 * g;
    bf16x8 kc[3][2];
#pragma unroll
    for (int t = 0; t < 3; ++t) { kc[t][0] = *(const bf16x8*)(kb + (size_t)t * 16 * 3072); kc[t][1] = *(const bf16x8*)(kb + (size_t)t * 16 * 3072 + 32); }
#pragma unroll 1
    for (int i = 0; i < 8; ++i) {
        s16x4 vv[4][3];
#pragma unroll
        for (int dt = 0; dt < 4; ++dt)
#pragma unroll
            for (int t = 0; t < 3; ++t) vv[dt][t] = *(const s16x4*)(vb + (size_t)dt * 16 * 32768 + 16 * t);
        f32x4 SA[4], SB[4];
#pragma unroll
        for (int t = 0; t < 3; ++t) { SA[t] = MFMA16(kc[t][0], qA0r, zero4); SA[t] = MFMA16(kc[t][1], qA1r, SA[t]); SB[t] = MFMA16(kc[t][0], qB0r, zero4); SB[t] = MFMA16(kc[t][1], qB1r, SB[t]); }
        __builtin_amdgcn_sched_barrier(0);
        { const bf16* kb2 = kb + ((i < 7) ? (size_t)64 * 3072 : 0);
#pragma unroll
          for (int t = 0; t < 3; ++t) { kc[t][0] = *(const bf16x8*)(kb2 + (size_t)t * 16 * 3072); kc[t][1] = *(const bf16x8*)(kb2 + (size_t)t * 16 * 3072 + 32); } }
        __builtin_amdgcn_sched_barrier(0);
        const LAS float* bp = RPB_L + (rs + i - r + 7) * 32;
        bias_mask(SA, bp, ixA); bias_mask(SB, bp, ixB);
        float aA, aB; bf16x8 pA0, pA1, pB0, pB1;
        sm_step<3>(SA, mA, lA, aA, pA0, pA1); sm_step<3>(SB, mB, lB, aB, pB0, pB1);
        const s16x4 z4 = {0, 0, 0, 0};
#pragma unroll
        for (int dt = 0; dt < 4; ++dt) { const bf16x8 va = cat8(vv[dt][0], vv[dt][1]), vb2 = cat8(vv[dt][2], z4);
            OA[dt] = OA[dt] * aA; OA[dt] = MFMA16(va, pA0, OA[dt]); OA[dt] = MFMA16(vb2, pA1, OA[dt]);
            OB[dt] = OB[dt] * aB; OB[dt] = MFMA16(va, pB0, OB[dt]); OB[dt] = MFMA16(vb2, pB1, OB[dt]); }
        kb += (size_t)64 * 3072; vb += 64;
    }
    bf16x8 qA0, qA1, qB0, qB1;
    q_frags<false>(QKG + rowA * 3072 + h * 64 + 8 * g, rope, r, cA, g, qA0, qA1);
    q_frags<false>(QKG + (rowA + 16) * 3072 + h * 64 + 8 * g, rope, r, cB, g, qB0, qB1);
#pragma unroll 1
    for (int cc = 0; cc < 4; ++cc) {
        f32x4 SA[4], SB[4];
#pragma unroll
        for (int ct = 0; ct < 4; ++ct) { const LAS bf16* kp = KC_L + (64 * cc + 16 * ct + lq) * ATT_KC_STRIDE + 8 * g;
            const bf16x8 k0 = *(const LAS bf16x8*)kp, k1 = *(const LAS bf16x8*)(kp + 32);
            SA[ct] = MFMA16(k0, qA0, zero4); SA[ct] = MFMA16(k1, qA1, SA[ct]); SB[ct] = MFMA16(k0, qB0, zero4); SB[ct] = MFMA16(k1, qB1, SB[ct]); }
        float aA, aB; bf16x8 pA0, pA1, pB0, pB1;
        sm_step<4>(SA, mA, lA, aA, pA0, pA1); sm_step<4>(SB, mB, lB, aB, pB0, pB1);
#pragma unroll
        for (int dt = 0; dt < 4; ++dt) { const LAS bf16* vp = VC_L + (16 * dt + lq) * ATT_VC_STRIDE + 64 * cc + 4 * g;
            const bf16x8 va = cat8(*(const LAS s16x4*)vp, *(const LAS s16x4*)(vp + 16)), vb2 = cat8(*(const LAS s16x4*)(vp + 32), *(const LAS s16x4*)(vp + 48));
            OA[dt] = OA[dt] * aA; OA[dt] = MFMA16(va, pA0, OA[dt]); OA[dt] = MFMA16(vb2, pA1, OA[dt]);
            OB[dt] = OB[dt] * aB; OB[dt] = MFMA16(va, pB0, OB[dt]); OB[dt] = MFMA16(vb2, pB1, OB[dt]); }
    }
    { float l = lA; l += __shfl_xor(l, 16); l += __shfl_xor(l, 32); const float inv = 1.0f / l; bf16* op = YNA + rowA * 512 + h * 64 + 4 * g;
#pragma unroll
      for (int dt = 0; dt < 4; ++dt) { const f32x4 o = OA[dt] * inv; u32x2 w; w.x = pk2(o[0], o[1]); w.y = pk2(o[2], o[3]); *(u32x2*)(op + 16 * dt) = w; } }
    { float l = lB; l += __shfl_xor(l, 16); l += __shfl_xor(l, 32); const float inv = 1.0f / l; bf16* op = YNA + (rowA + 16) * 512 + h * 64 + 4 * g;
#pragma unroll
      for (int dt = 0; dt < 4; ++dt) { const f32x4 o = OB[dt] * inv; u32x2 w; w.x = pk2(o[0], o[1]); w.y = pk2(o[2], o[3]); *(u32x2*)(op + 16 * dt) = w; } }
}

struct Args { const float* in[26]; float* out; unsigned char* ws; int ph_lo, ph_hi; };
enum { I_X = 0, I_C, I_CTX, I_CCTX, I_WADA, I_BADA, I_N1G, I_N2G, I_WIN, I_RPB, I_HCW, I_HCB, I_HW1, I_HB1, I_HW2, I_HB2, I_HFR, I_HW3, I_HBIAS, I_WNAO, I_WHYO, I_WOUT, I_FW1, I_FW3, I_FW2, I_FING };
constexpr int NPHASE = 10;

__global__ void __launch_bounds__(NT, 2) mega_fwd(Args args) {
    extern __shared__ __attribute__((aligned(16))) unsigned char lds_raw[];
    LAS unsigned char* lds = (LAS unsigned char*)lds_raw;
    cg::grid_group grid = cg::this_grid();
    const int tid = threadIdx.x, lane = tid & 63, wave = __builtin_amdgcn_readfirstlane(tid >> 6);
    const int G = gridDim.x, bx = blockIdx.x;
    const int vcu = (G % 8 == 0) ? (bx % 8) * (G / 8) + bx / 8 : bx;
    const int gw = vcu * NW + wave, NGW = G * NW;
    unsigned char* ws = args.ws;
    const float* x = args.in[I_X]; float* out = args.out;
    bf16* WT_in = (bf16*)(ws + WS_WIN); bf16* WT_nao = (bf16*)(ws + WS_WNAO); bf16* WT_hyo = (bf16*)(ws + WS_WHYO); bf16* WT_out = (bf16*)(ws + WS_WOUT);
    bf16* WT_13 = (bf16*)(ws + WS_W13); bf16* WT_2 = (bf16*)(ws + WS_W2);
    float* mod = (float*)(ws + WS_MOD); f32x2* rope = (f32x2*)(ws + WS_ROPE); float* hid2 = (float*)(ws + WS_HID2);
    float* K2 = (float*)(ws + WS_K2); bf16* YHY = (bf16*)(ws + WS_K2);
    bf16* H = (bf16*)(ws + WS_H); bf16* YNA = (bf16*)(ws + WS_H);
    bf16* QKG = (bf16*)(ws + WS_QKG); bf16* HID = (bf16*)(ws + WS_QKG);
    bf16* VHT = (bf16*)out; float* M1 = out;
    bf16* YHT = (bf16*)(ws + WS_YHT); bf16* MB = (bf16*)(ws + WS_MB);
    bf16* KC = (bf16*)(ws + WS_KC); bf16* VCT = (bf16*)(ws + WS_VCT); float* Z1T = (float*)(ws + WS_Z1T);
    const int lo = args.ph_lo, hi = args.ph_hi;
    unsigned long long* rowss2 = (unsigned long long*)(ws + WS_RSS2); unsigned long long* rowss3 = (unsigned long long*)(ws + WS_RSS3); float* sW = (float*)(ws + WS_SW);
    { volatile LAS unsigned* MISC = (volatile LAS unsigned*)(lds + MISC_OFF);
      if (tid < 64) MISC[tid] = 0u; }
    __syncthreads();
    XcdBarrier bar = xcd_barrier_post((unsigned*)(ws + WS_CTL), (volatile LAS unsigned*)(lds + MISC_OFF) + 8);
    if (lo < 0) grid.sync();
#define IN(k) (lo <= (k) && (k) < hi)
#define SEAM(k) do { if (IN(k) && IN((k) + 1)) xcd_barrier(bar); } while (0)

    if (IN(0)) {
        for (int task = vcu; task < NMOD / 64; task += G) {
            LAS float* sc = (LAS float*)lds; LAS float* red = (LAS float*)(lds + 40960);
            for (int i = tid; i < 9 * 1024; i += NT) { const int b = i >> 10, k = i & 1023; const float v = (b < 8) ? args.in[I_C][b * 1024 + k] : args.in[I_CCTX][k]; sc[i] = v / (1.0f + __expf(-v)); }
            __syncthreads();
            const int j = 64 * task + lane, k0 = 128 * wave; float acc[9];
#pragma unroll
            for (int b = 0; b < 9; ++b) acc[b] = 0.f;
            const float* wp = args.in[I_WADA] + (size_t)k0 * NMOD + j;
#pragma unroll 32
            for (int kk = 0; kk < 128; ++kk) { const float w = __builtin_nontemporal_load(wp + (size_t)kk * NMOD);
#pragma unroll
                for (int b = 0; b < 9; ++b) acc[b] += sc[b * 1024 + k0 + kk] * w; }
#pragma unroll
            for (int b = 0; b < 9; ++b) red[(wave * 9 + b) * 64 + lane] = acc[b];
            __syncthreads();
            for (int i = tid; i < 9 * 64; i += NT) { const int b = i >> 6, l = i & 63; float s = 0.f;
#pragma unroll
                for (int w = 0; w < 8; ++w) s += red[(w * 9 + b) * 64 + l];
                mod[b * NMOD + 64 * task + l] = s + args.in[I_BADA][64 * task + l]; }
            __syncthreads();
        }
        for (int i = vcu * NT + tid; i < 2 * MTOK; i += G * NT) { if (i < MTOK) rowss2[i] = 0ull; else rowss3[i - MTOK] = 0ull; }
        for (int i = bx * NT + tid; i < 1024; i += G * NT) { const int pos = i >> 4, fi = i & 15; const float inv = powf(10000.0f, -(float)fi / 16.0f), ang = (float)pos * inv; f32x2 cs; cs.x = cosf(ang); cs.y = sinf(ang); rope[i] = cs; }
        for (int p = gw; p < 4096; p += NGW) {
            const float wv = 6.283185307179586f * (float)p / 4096.0f; float zv = 0.f;
            if (lane == 0) zv = (float)p / 4095.0f;
            else if (lane <= 16) { const float band = 1e-4f + (float)(lane - 1) * ((15.0f - 1e-4f) / 15.0f); zv = cosf(band * wv); }
            else if (lane <= 32) { const float band = 1e-4f + (float)(lane - 17) * ((15.0f - 1e-4f) / 15.0f); zv = sinf(-band * wv); }
            const float fr = args.in[I_HFR][lane];
            float a = args.in[I_HB1][lane];
#pragma unroll 3
            for (int e = 0; e < 33; ++e) a += __shfl(zv, e) * args.in[I_HW1][e * 64 + lane];
            const float h1 = sinf(fr * a);
            float a2 = args.in[I_HB2][lane];
#pragma unroll 8
            for (int i = 0; i < 64; ++i) a2 += __shfl(h1, i) * args.in[I_HW2][i * 64 + lane];
            hid2[p * 64 + lane] = sinf(fr * a2);
        }
        { LAS float* scr = (LAS float*)(lds + wave * 16384);
          constexpr int I0 = 16 * 160, I4 = 16 * 176, NIT = I0 + I4;
          const int ngv = NMOD / 64;
          const bool spare = G >= 2 * ngv; const int tw0 = spare ? (vcu - ngv) * NW + wave : gw, tnw = spare ? (G - ngv) * NW : NGW;
          if (!spare || vcu >= ngv)
          for (int it = tw0; it < NIT; it += tnw) {
              int r = it; const int l31 = lane & 31;
              if (r < I0) { const int kb = r / 160, nb = r % 160; tr_item(args.in[I_WIN], 5120, mapcol_in(32 * nb + l31), WT_in, 1024, 32 * nb, 64 * kb, scr, lane); continue; } r -= I0;
              { const int kb = r / 176, nb = r % 176, n0 = 32 * nb, tile = n0 >> 8, within = n0 & 255;
                  tr_item((within < 128) ? args.in[I_FW1] : args.in[I_FW3], FF, tile * 128 + (within & 127) + l31, WT_13, 1024, n0, 64 * kb, scr, lane); }
          } }
    }
    SEAM(0);

    if (IN(1)) {
        {
          const int m0 = gw * (MALL / (NGW)), nrow = MALL / NGW;
          if (MALL % NGW == 0) {
            int bcur = -1; f32x4 gsc[4], shv[4];
            for (int mm = 0; mm < nrow; mm += 4) {
                f32x4 v[4][4];
#pragma unroll
                for (int q = 0; q < 4; ++q) { const int m = m0 + mm + q; if (mm + q < nrow) { const float* src = (m < MTOK) ? x + (size_t)m * DM : args.in[I_CTX] + (size_t)(m - MTOK) * DM;
#pragma unroll
                    for (int j = 0; j < 4; ++j) v[q][j] = __builtin_nontemporal_load((const f32x4*)src + lane + 64 * j); } }
#pragma unroll
                for (int q = 0; q < 4; ++q) { const int m = m0 + mm + q; if (mm + q < nrow) {
                    const int b = (m < MTOK) ? (m >> 12) : 8;
                    if (b != bcur) { bcur = b; const float* mb = mod + (size_t)b * NMOD;
#pragma unroll
                        for (int j = 0; j < 4; ++j) { const int k = 4 * (lane + 64 * j); gsc[j] = *(const f32x4*)(args.in[I_N1G] + k) * (*(const f32x4*)(mb + 1024 + k) + 1.0f); shv[j] = *(const f32x4*)(mb + k); } }
                    float ssum = 0.f;
#pragma unroll
                    for (int j = 0; j < 4; ++j) ssum += (v[q][j].x * v[q][j].x + v[q][j].y * v[q][j].y) + (v[q][j].z * v[q][j].z + v[q][j].w * v[q][j].w);
                    const float rstd = __builtin_amdgcn_rsqf(wave_sum(ssum) * (1.f / 1024.f) + 1e-6f);
#pragma unroll
                    for (int j = 0; j < 4; ++j) { const f32x4 y = v[q][j] * rstd * gsc[j] + shv[j]; u32x2 w; w.x = pk2(y.x, y.y); w.y = pk2(y.z, y.w); *(u32x2*)(H + (size_t)m * DM + 4 * (lane + 64 * j)) = w; } } }
            }
          } else {
            for (int m = gw; m < MALL; m += NGW) {
                const bool lat = m < MTOK; const float* src = lat ? x + (size_t)m * DM : args.in[I_CTX] + (size_t)(m - MTOK) * DM; const float* mb = mod + (size_t)(lat ? (m >> 12) : 8) * NMOD;
                norm_row(src, H + (size_t)m * DM, args.in[I_N1G], mb, mb + 1024, lane); }
          } }
        for (int n = gw; n < 2 * FF; n += NGW) {
            const u32x4 wa = *(const u32x4*)(WT_13 + (size_t)n * 1024 + 8 * lane), wb = *(const u32x4*)(WT_13 + (size_t)n * 1024 + 512 + 8 * lane);
            float wf[16];
            wf[0] = __uint_as_float(wa.x << 16); wf[1] = __uint_as_float(wa.x & 0xffff0000u); wf[2] = __uint_as_float(wa.y << 16); wf[3] = __uint_as_float(wa.y & 0xffff0000u);
            wf[4] = __uint_as_float(wa.z << 16); wf[5] = __uint_as_float(wa.z & 0xffff0000u); wf[6] = __uint_as_float(wa.w << 16); wf[7] = __uint_as_float(wa.w & 0xffff0000u);
            wf[8] = __uint_as_float(wb.x << 16); wf[9] = __uint_as_float(wb.x & 0xffff0000u); wf[10] = __uint_as_float(wb.y << 16); wf[11] = __uint_as_float(wb.y & 0xffff0000u);
            wf[12] = __uint_as_float(wb.z << 16); wf[13] = __uint_as_float(wb.z & 0xffff0000u); wf[14] = __uint_as_float(wb.w << 16); wf[15] = __uint_as_float(wb.w & 0xffff0000u);
#pragma unroll
            for (int b = 0; b < 8; ++b) { const float* sp = mod + (size_t)b * NMOD + 3072 + 8 * lane;
                const f32x4 s0 = *(const f32x4*)sp, s1 = *(const f32x4*)(sp + 4), s2 = *(const f32x4*)(sp + 512), s3 = *(const f32x4*)(sp + 516);
                float d = (wf[0] * s0[0] + wf[1] * s0[1]) + (wf[2] * s0[2] + wf[3] * s0[3]) + (wf[4] * s1[0] + wf[5] * s1[1]) + (wf[6] * s1[2] + wf[7] * s1[3])
                        + (wf[8] * s2[0] + wf[9] * s2[1]) + (wf[10] * s2[2] + wf[11] * s2[3]) + (wf[12] * s3[0] + wf[13] * s3[1]) + (wf[14] * s3[2] + wf[15] * s3[3]);
                d = wave_sum(d); if (lane == 0) sW[b * 2 * FF + n] = d; }
        }
        for (int task = bx; task < 256; task += G) {
            const int pc = task >> 5, col0 = 64 * (task & 31);
            LAS float* w3s = (LAS float*)lds;
            for (int i = tid; i < 4096; i += NT) { const int j = i >> 6, cc = i & 63; w3s[cc * 64 + j] = args.in[I_HW3][j * 2048 + col0 + cc]; }
            __syncthreads();
            const int p = 512 * pc + tid; f32x4 hv[16];
#pragma unroll
            for (int q = 0; q < 16; ++q) hv[q] = *(const f32x4*)(hid2 + (size_t)p * 64 + 4 * q);
            const int d = col0 >> 10, n = (col0 >> 9) & 1; const float tn = (float)p / 4095.0f;
            const float min_decay = -3.0701134573253945f, max_decay = -15.350567286626973f;
#pragma unroll 1
            for (int cc = 0; cc < 64; ++cc) {
                float acc = 0.f;
#pragma unroll
                for (int q = 0; q < 16; ++q) { const f32x4 w = *(const LAS f32x4*)(w3s + cc * 64 + 4 * q); acc += (hv[q].x * w.x + hv[q].y * w.y) + (hv[q].z * w.z + hv[q].w * w.w); }
                const int c = (col0 + cc) & 511; const float delta = fabsf(min_decay + (float)c * ((max_decay - min_decay) / 511.0f));
                float val = acc * __expf(-tn * delta);
                float* kf = K2 + (size_t)(n * 512 + c) * 8192;
                if (d == 0) { if (p == 0) val += args.in[I_HBIAS][n * 512 + c]; kf[p] = val; }
                else { if (p == 0) kf[4096] = 0.f; else kf[8192 - p] = val; }
            }
            __syncthreads();
        }
    }
    SEAM(1);

    if (IN(2)) {
        { pg8::Gemm g{H, WT_in, MTOK, 3072, 1024}; pg8::StaticOrder S; S.init(MTOK, 3072, G, bx); ep::EpiQKG E{QKG, rope};
          pg8::gemm_phase<ep::EpiQKG, pg8::StaticOrder, true, true>(lds, g, S, E); }
        { pg8::Gemm g{WT_in + (size_t)3072 * 1024, H, 2048, MTOK, 1024}; pg8::StaticOrder S; S.init(2048, MTOK, G, bx); ep::EpiPlain E{VHT, MTOK};
          pg8::gemm_phase<ep::EpiPlain, pg8::StaticOrder, true, true>(lds, g, S, E); }
        { pg8::Gemm g{H + (size_t)MTOK * 1024, WT_in + (size_t)512 * 1024, MCTX, 512, 1024}; pg8::StaticOrder S; S.init(MCTX, 512, G, bx); ep::EpiPlain E{KC, 512};
          pg8::gemm_phase<ep::EpiPlain, pg8::StaticOrder, true, true>(lds, g, S, E); }
        { pg8::Gemm g{WT_in + (size_t)3072 * 1024, H + (size_t)MTOK * 1024, 512, MCTX, 1024}; pg8::StaticOrder S; S.init(512, MCTX, G, (bx + G - 16) % G); ep::EpiPlain E{VCT, MCTX};
          pg8::gemm_phase<ep::EpiPlain, pg8::StaticOrder, true, true>(lds, g, S, E); }
    }
    SEAM(2);

    if (IN(3)) {
        LAS f32x2* XP = (LAS f32x2*)lds; LAS f32x2* KHP = XP + XPAD;
        const float* cw = args.in[I_HCW]; const float* cb = args.in[I_HCB];
        const int hf = tid >> 8, uu = tid & 255, ulo = uu & 15, uhi = uu >> 4;
        const int pA0 = uu + (uu >> 4), pA = hf * 4352 + pA0, pB = hf * 4352 + uhi * 272 + ulo, pC = 17 * (hf * 256 + uu);
        const int t0 = 8 * tid, pF = t0 + (tid >> 1);
        const float thA = (float)uu * (1.0f / 4096.0f), thB = (float)ulo * (1.0f / 256.0f), thE = (float)uu * (1.0f / 8192.0f);
#define CONV_TW(T, TH, Z) Tw T; { float th_ = (TH); asm volatile("" : "+v"(th_)); mk_tw<Z>(T, th_); }
#define CONV_E(E) f32x2 E; { float th_ = thE; asm volatile("" : "+v"(th_)); E.x = __builtin_amdgcn_cosf(th_); E.y = -__builtin_amdgcn_sinf(th_); }
        const bool hasl = tid > 0, hasr = tid < 511;
        for (int c = vcu; c < 512; c += G) {
#pragma unroll 1
            for (int n = 0; n < 2; ++n) {
                f32x2 v[16];
                const bf16* hvrow = VHT + (size_t)(512 + c) * MTOK + t0;
                const float* zrow = Z1T + (size_t)c * 8 * 4096 + t0;
                u32x4 pa0, pa1, pc0, pc1; unsigned short ph0l = 0, ph0r = 0, ph1l = 0, ph1r = 0;
#define CONV_LOAD_U(B0) do { if (n == 0) { pa0 = __builtin_nontemporal_load((const u32x4*)(hvrow + (B0) * 4096)); pc0 = __builtin_nontemporal_load((const u32x4*)(hvrow + ((B0) + 1) * 4096)); \
        ph0l = hasl ? hvrow[(B0) * 4096 - 1] : (unsigned short)0; ph0r = hasr ? hvrow[(B0) * 4096 + 8] : (unsigned short)0; \
        ph1l = hasl ? hvrow[((B0) + 1) * 4096 - 1] : (unsigned short)0; ph1r = hasr ? hvrow[((B0) + 1) * 4096 + 8] : (unsigned short)0; pa1 = pa0; pc1 = pc0; } \
    else { pa0 = *(const u32x4*)(zrow + (B0) * 4096); pa1 = *(const u32x4*)(zrow + (B0) * 4096 + 4); pc0 = *(const u32x4*)(zrow + ((B0) + 1) * 4096); pc1 = *(const u32x4*)(zrow + ((B0) + 1) * 4096 + 4); } } while (0)
                CONV_LOAD_U(0);
                { const float* k2 = K2 + (size_t)(n * 512 + c) * 8192 + uu;
                  { CONV_E(E)
#pragma unroll
                  for (int k = 0; k < 16; ++k) { const float a = k2[256 * k], b = k2[4096 + 256 * k];
                      if (hf == 0) { v[k].x = a + b; v[k].y = 0.f; } else { const f32x2 w = ec32(E, k); v[k] = w * (a - b); } } }
                  { CONV_TW(TA, thA, false) r16_dif(v, TA); }
#pragma unroll
                  for (int k = 0; k < 16; ++k) KHP[pA + 272 * k] = v[k];
                  __syncthreads();
#pragma unroll
                  for (int k = 0; k < 16; ++k) v[k] = KHP[pB + 17 * k];
                  { CONV_TW(TB, thB, false) r16_dif(v, TB); }
#pragma unroll
                  for (int k = 0; k < 16; ++k) KHP[pB + 17 * k] = v[k];
                  __syncthreads();
#pragma unroll
                  for (int k = 0; k < 16; ++k) v[k] = KHP[pC + k];
                  r16_dif0(v);
#pragma unroll
                  for (int k = 0; k < 16; ++k) KHP[pC + k] = v[k] * (1.0f / 8192.0f);
                  __syncthreads(); }
                const int gcol = (n == 0 ? 512 : 1024) + c;
                const float gw0 = cw[gcol], gw1 = cw[1536 + gcol], gw2 = cw[3072 + gcol], gb = cb[gcol];
                const float vw0 = cw[c], vw1 = cw[1536 + c], vw2 = cw[3072 + c], vb = cb[c];
                const bf16* grow = VHT + (size_t)(512 + gcol) * MTOK + t0;
#pragma unroll 1
                for (int bp = 0; bp < 4; ++bp) {
                    const int b0 = 2 * bp, b1 = b0 + 1;
                    float u0[8], u1[8];
                    if (n == 0) { float raw[10]; unpack8(pa0, ph0l, ph0r, hasl, hasr, raw); sconv8(raw, vw0, vw1, vw2, vb, u0); unpack8(pc0, ph1l, ph1r, hasl, hasr, raw); sconv8(raw, vw0, vw1, vw2, vb, u1); }
                    else {
#pragma unroll
                        for (int e = 0; e < 4; ++e) { u0[e] = __uint_as_float(pa0[e]); u0[4 + e] = __uint_as_float(pa1[e]); u1[e] = __uint_as_float(pc0[e]); u1[4 + e] = __uint_as_float(pc1[e]); } }
                    f32x2 E0; { float th_ = (float)tid * (1.0f / 1024.0f); asm volatile("" : "+v"(th_)); E0.x = __builtin_amdgcn_cosf(th_); E0.y = -__builtin_amdgcn_sinf(th_); }
#pragma unroll
                    for (int e = 0; e < 8; ++e) { f32x2 w; w.x = u0[e]; w.y = u1[e]; XP[pF + e] = w; XP[4352 + pF + e] = cmul_bf(w, tw8(E0, e)); }
                    if (bp < 3) CONV_LOAD_U(b0 + 2);
                    __syncthreads();
#pragma unroll
                    for (int k = 0; k < 16; ++k) v[k] = XP[pA + 272 * k];
                    { CONV_TW(TA, thA, false) r16_dif(v, TA); }
#pragma unroll
                    for (int k = 0; k < 16; ++k) XP[pA + 272 * k] = v[k];
                    __syncthreads();
#pragma unroll
                    for (int k = 0; k < 16; ++k) v[k] = XP[pB + 17 * k];
                    { CONV_TW(TB, thB, false) r16_dif(v, TB); }
#pragma unroll
                    for (int k = 0; k < 16; ++k) XP[pB + 17 * k] = v[k];
                    __syncthreads();
#pragma unroll
                    for (int k = 0; k < 16; ++k) v[k] = XP[pC + k];
                    r16_dif0(v);
#pragma unroll
                    for (int k = 0; k < 16; ++k) v[k] = cmul_bf(v[k], KHP[pC + k]);
                    r16_dit0(v);
#pragma unroll
                    for (int k = 0; k < 16; ++k) XP[pC + k] = v[k];
                    const u32x4 g0w = __builtin_nontemporal_load((const u32x4*)(grow + b0 * 4096)), g1w = __builtin_nontemporal_load((const u32x4*)(grow + b1 * 4096));
                    const unsigned short g0l = hasl ? grow[b0 * 4096 - 1] : (unsigned short)0, g0r = hasr ? grow[b0 * 4096 + 8] : (unsigned short)0;
                    const unsigned short g1l = hasl ? grow[b1 * 4096 - 1] : (unsigned short)0, g1r = hasr ? grow[b1 * 4096 + 8] : (unsigned short)0;
                    __syncthreads();
#pragma unroll
                    for (int k = 0; k < 16; ++k) v[k] = XP[pB + 17 * k];
                    { CONV_TW(TB, thB, false) r16_dit(v, TB); }
#pragma unroll
                    for (int k = 0; k < 16; ++k) XP[pB + 17 * k] = v[k];
                    __syncthreads();
#pragma unroll
                    for (int k = 0; k < 16; ++k) v[k] = XP[pA + 272 * k];
                    { CONV_TW(TA, thA, false) r16_dit(v, TA); }
#pragma unroll
                    for (int k = 0; k < 16; ++k) XP[pA + 272 * k] = v[k];
                    __syncthreads();
                    float raw[10], ga[8], gc[8];
                    unpack8(g0w, g0l, g0r, hasl, hasr, raw); sconv8(raw, gw0, gw1, gw2, gb, ga); unpack8(g1w, g1l, g1r, hasl, hasr, raw); sconv8(raw, gw0, gw1, gw2, gb, gc);
                    float y0[8], y1[8];
#pragma unroll
                    for (int e = 0; e < 8; ++e) { const f32x2 y = XP[pF + e] + cmulc_bf(XP[4352 + pF + e], tw8(E0, e)); y0[e] = y.x * ga[e]; y1[e] = y.y * gc[e]; }
                    if (n == 0) { float* z0 = Z1T + ((size_t)c * 8 + b0) * 4096 + t0; float* z1 = Z1T + ((size_t)c * 8 + b1) * 4096 + t0;
                        *(f32x4*)z0 = (f32x4){y0[0], y0[1], y0[2], y0[3]}; *(f32x4*)(z0 + 4) = (f32x4){y0[4], y0[5], y0[6], y0[7]};
                        *(f32x4*)z1 = (f32x4){y1[0], y1[1], y1[2], y1[3]}; *(f32x4*)(z1 + 4) = (f32x4){y1[4], y1[5], y1[6], y1[7]}; }
                    else { u32x4 w0, w1; w0.x = pk2(y0[0], y0[1]); w0.y = pk2(y0[2], y0[3]); w0.z = pk2(y0[4], y0[5]); w0.w = pk2(y0[6], y0[7]);
                        w1.x = pk2(y1[0], y1[1]); w1.y = pk2(y1[2], y1[3]); w1.z = pk2(y1[4], y1[5]); w1.w = pk2(y1[6], y1[7]);
                        *(u32x4*)(YHT + (size_t)c * MTOK + b0 * 4096 + t0) = w0; *(u32x4*)(YHT + (size_t)c * MTOK + b1 * 4096 + t0) = w1; }
                }
            }
        }
        __syncthreads();
        for (int u = vcu; u < 256; u += G) {
            const int bh = u >> 2, b = bh >> 3, h = bh & 7, r0 = 16 * (u & 3);
            { LAS bf16* KC_L = (LAS bf16*)(lds + ATT_KC_OFF); LAS bf16* VC_L = (LAS bf16*)(lds + ATT_VC_OFF); LAS float* RPB_L = (LAS float*)(lds + ATT_RPB_OFF);
              for (int i = tid; i < 256 * 8; i += NT) { const int key = i >> 3, seg = i & 7; *(LAS u32x4*)(KC_L + key * ATT_KC_STRIDE + seg * 8) = *(const u32x4*)(KC + ((size_t)b * 256 + key) * 512 + h * 64 + seg * 8); }
              for (int i = tid; i < 64 * 32; i += NT) { const int dh = i >> 5, seg = i & 31; *(LAS u32x4*)(VC_L + dh * ATT_VC_STRIDE + seg * 8) = *(const u32x4*)(VCT + (size_t)(h * 64 + dh) * 2048 + (size_t)b * 256 + seg * 8); }
              for (int i = tid; i < 15 * 32; i += NT) { const int rr = i >> 5, cc = i & 31; RPB_L[i] = (cc < 31) ? args.in[I_RPB][h * 465 + rr * 31 + cc] * 1.4426950408889634f : -1e30f; } }
            __syncthreads();
#pragma unroll 1
            for (int it = 0; it < 4; ++it) attn_task32(QKG, VHT, lds, rope, YNA, b, h, r0 + 4 * it + (wave >> 1), wave & 1, lane);
            __syncthreads();
        }
    }
    SEAM(3);

    if (IN(4)) {
        { LAS float* scr = (LAS float*)(lds + wave * 16384);
          constexpr int I1 = 8 * 32, I2 = 8 * 32, I3 = 16 * 32, I5 = 44 * 32, NIT = I1 + I2 + I3 + I5;
          for (int it = gw; it < NIT; it += NGW) {
              int r = it; const int l31 = lane & 31;
              if (r < I1) { const int kb = r / 32, nb = r % 32; tr_item(args.in[I_WNAO], 1024, 32 * nb + l31, WT_nao, 512, 32 * nb, 64 * kb, scr, lane); continue; } r -= I1;
              if (r < I2) { const int kb = r / 32, nb = r % 32; tr_item(args.in[I_WHYO], 1024, 32 * nb + l31, WT_hyo, 512, 32 * nb, 64 * kb, scr, lane); continue; } r -= I2;
              if (r < I3) { const int kb = r / 32, nb = r % 32; tr_item(args.in[I_WOUT], 1024, 32 * nb + l31, WT_out, 1024, 32 * nb, 64 * kb, scr, lane); continue; } r -= I3;
              { const int kb = r / 32, nb = r % 32; tr_item(args.in[I_FW2], 1024, 32 * nb + l31, WT_2, FF, 32 * nb, 64 * kb, scr, lane); }
          } }
        LAS unsigned short* tile = (LAS unsigned short*)(lds + wave * 16384);
        for (int tl = gw; tl < 4096; tl += NGW) {
            const int c0 = 64 * (tl & 7), tok0 = 64 * (tl >> 3);
            u32x4 rr[8];
#pragma unroll
            for (int q = 0; q < 8; ++q) rr[q] = __builtin_nontemporal_load((const u32x4*)(YHT + (size_t)(c0 + 8 * q + (lane >> 3)) * MTOK + tok0 + 8 * (lane & 7)));
#pragma unroll
            for (int q = 0; q < 8; ++q) *(LAS u32x4*)(tile + (8 * q + (lane >> 3)) * 72 + 8 * (lane & 7)) = rr[q];
            LDS_WAIT(); asm volatile("" ::: "memory");
#pragma unroll
            for (int q = 0; q < 8; ++q) { const int tok = 8 * q + (lane >> 3); const LAS unsigned short* tp = tile + (8 * (lane & 7)) * 72 + tok;
                u32x4 w; w.x = (unsigned)tp[0] | ((unsigned)tp[72] << 16); w.y = (unsigned)tp[144] | ((unsigned)tp[216] << 16); w.z = (unsigned)tp[288] | ((unsigned)tp[360] << 16); w.w = (unsigned)tp[432] | ((unsigned)tp[504] << 16);
                *(u32x4*)(YHY + (size_t)(tok0 + tok) * 512 + c0 + 8 * (lane & 7)) = w; }
            LDS_WAIT(); asm volatile("" ::: "memory");
        }
    }
    SEAM(4);

    if (IN(5)) {
        pg8::Gemm g0{YNA, WT_nao, MTOK, 1024, 512}, g1{YHY, WT_hyo, MTOK, 1024, 512}; ep::DualOrder S; S.b.init(MTOK, 1024, G, bx); ep::EpiGateDual E{QKG, MB};
        pg8::gemm_phase_dual<ep::EpiGateDual, ep::DualOrder, true, true>(lds, g0, g1, S, E);
    }
    SEAM(5);

    if (IN(6)) {
        pg8::Gemm g{MB, WT_out, MTOK, 1024, 1024}; pg8::StaticOrder S; S.init(MTOK, 1024, G, bx); ep::EpiRes1 E{x, (bf16*)(ws + WS_Z1T), mod, args.in[I_N2G], H, rowss2};
        pg8::gemm_phase<ep::EpiRes1, pg8::StaticOrder, true, true>(lds, g, S, E);
    }
    SEAM(6);

    if (IN(7)) {
        pg8::Gemm g{H, WT_13, MTOK, 2 * FF, 1024}; pg8::StaticOrder S; S.init(MTOK, 2 * FF, G, bx); ep::EpiFFN E{HID, rowss2, sW};
        pg8::gemm_phase<ep::EpiFFN, pg8::StaticOrder, true, true>(lds, g, S, E);
    }
    SEAM(7);

    if (IN(8)) {
        pg8::Gemm g{HID, WT_2, MTOK, 1024, FF}; pg8::StaticOrder S; S.init(MTOK, 1024, G, bx); ep::EpiRes2 E{out, mod, rowss3, (const bf16*)(ws + WS_Z1T)};
        pg8::gemm_phase<ep::EpiRes2, pg8::StaticOrder, true, true>(lds, g, S, E);
    }
    SEAM(8);

    if (IN(9)) {
        const f32x4* fg = (const f32x4*)args.in[I_FING]; f32x4* o4 = (f32x4*)out;
        const int nth = G * NT; constexpr int TOT = MTOK * 256;
        for (int i = vcu * NT + tid; i < TOT; i += 4 * nth) {
            f32x4 v[4];
#pragma unroll
            for (int q = 0; q < 4; ++q) if (i + q * nth < TOT) v[q] = __builtin_nontemporal_load(o4 + i + q * nth);
#pragma unroll
            for (int q = 0; q < 4; ++q) { const int ii = i + q * nth; if (ii < TOT) { const float rstd = __builtin_amdgcn_rsqf((float)rowss3[ii >> 8] * (1.0f / (1024.0f * 1048576.0f)) + 1e-6f); __builtin_nontemporal_store(v[q] * rstd * fg[ii & 255], o4 + ii); } }
        }
    }
#undef IN
#undef SEAM
}

#ifndef MK_MULTI
#define MK_MULTI 0
#endif
extern "C" void kernel_launch(void* const* d_in, const int* in_sizes, int n_in, void* d_out, int out_size, void* d_ws, size_t ws_size, hipStream_t stream) {
    static int grid = 0;
    if (grid == 0) {
        if (n_in != 26 || out_size != MTOK * DM || ws_size < WS_END) { fprintf(stderr, "kernel_launch: unexpected shapes (n_in %d, out %d, ws %zu)\n", n_in, out_size, ws_size); grid = -1; return; }
        int dev = 0, cus = 0, per_cu = 0;
        (void)hipGetDevice(&dev); (void)hipDeviceGetAttribute(&cus, hipDeviceAttributeMultiprocessorCount, dev);
        if (hipFuncSetAttribute((const void*)mega_fwd, hipFuncAttributeMaxDynamicSharedMemorySize, LDS_BYTES) != hipSuccess) { fprintf(stderr, "kernel_launch: hipFuncSetAttribute failed\n"); grid = -1; return; }
        if (hipOccupancyMaxActiveBlocksPerMultiprocessor(&per_cu, (const void*)mega_fwd, NT, LDS_BYTES) != hipSuccess || per_cu < 1) { fprintf(stderr, "kernel_launch: occupancy query gave %d\n", per_cu); per_cu = 1; }
        (void)hipGetLastError();
        grid = cus * per_cu;
        fprintf(stderr, "kernel_launch: %d CUs x %d = grid %d\n", cus, per_cu, grid);
    }
    if (grid < 0) return;
    (void)hipMemsetAsync((unsigned char*)d_ws + WS_CTL, 0, CTL_BYTES, stream);
    Args a{};
    for (int i = 0; i < 26; ++i) a.in[i] = (const float*)d_in[i];
    a.out = (float*)d_out; a.ws = (unsigned char*)d_ws;
#if MK_MULTI
    for (int p = 0; p < NPHASE; ++p) { a.ph_lo = p; a.ph_hi = p + 1; hipLaunchKernelGGL(mega_fwd, dim3(grid), dim3(NT), LDS_BYTES, stream, a); }
#else
    a.ph_lo = 0; a.ph_hi = NPHASE;
    void* kargs[] = {&a};
    hipError_t e = hipLaunchCooperativeKernel((const void*)mega_fwd, dim3(grid), dim3(NT), kargs, LDS_BYTES, stream);
    if (e != hipSuccess) fprintf(stderr, "kernel_launch: cooperative launch failed: %s (grid %d)\n", hipGetErrorString(e), grid);
#endif
}
```

```cpp
#include <hip/hip_runtime.h>
#include <hip/hip_cooperative_groups.h>
#include <cstdio>
#include <cstdint>
namespace cg = cooperative_groups;
namespace pg8 {
#define PG8_LAS __attribute__((address_space(3)))
typedef unsigned short bf16_t;
typedef short bf16x8 __attribute__((ext_vector_type(8)));
typedef float f32x4 __attribute__((ext_vector_type(4)));
typedef unsigned u32x4 __attribute__((ext_vector_type(4)));
constexpr int BM = 256, BK = 64, HALF = 128, HTB = HALF * BK * 2  , STAGE_BYTES = 8 * HTB, NXCD = 8, WGM = 8;

__host__ __device__ __forceinline__ int lds_byte(int r, int c) { const int st = (r >> 4) * 2 + (c >> 5), rr = r & 15, cc = c & 31, ob = rr * 64 + cc * 2; return st * 1024 + (ob ^ (((ob >> 9) & 1) << 5)); }
__host__ __device__ __forceinline__ void stage_rc(int b, int& R, int& C) { const int st = b / 1024, sb = b % 1024, swz = sb ^ (((sb >> 9) & 1) << 5); R = (st >> 1) * 16 + swz / 64; C = (st & 1) * 32 + (swz % 64) / 2; }
__host__ __device__ __forceinline__ int perm32(int rho) { const int n = rho >> 4, i = rho & 15; return 8 * (i >> 2) + 4 * n + (i & 3); }

struct Unit { int pm, pn; };
struct Gemm { const bf16_t* A; const bf16_t* Bt; int M, N, K; };

struct StaticOrder {
    int nM, nN, nwg, G, c;
    __host__ __device__ void init(int M, int N, int G_, int c_) { nM = M / BM; nN = N / BM; nwg = nM * nN; G = G_; c = c_; }
    __host__ __device__ bool next(int i, Unit& u) const {
        const long L = (long)i * G + c; if (L >= nwg) return false;
        int wgid = (int)L; { const int q = nwg / NXCD, r = nwg % NXCD, xcd = wgid % NXCD, off = wgid / NXCD; wgid = (xcd < r ? xcd * (q + 1) : r * (q + 1) + (xcd - r) * q) + off; }
        const int nig = WGM * nN, gid = wgid / nig, fm = gid * WGM, gsz = (nM - fm) < WGM ? (nM - fm) : WGM;
        u.pm = fm + ((wgid % nig) % gsz); u.pn = (wgid % nig) / gsz; return true;
    }
    __device__ __forceinline__ void a_ready(const Unit&) const {}
    __device__ __forceinline__ void done(const Unit&) const {}
};

__device__ __forceinline__ unsigned cvt_pk_bf16(float lo, float hi) { unsigned r; asm volatile("v_cvt_pk_bf16_f32 %0, %1, %2" : "=v"(r) : "v"(lo), "v"(hi)); return r; }
template <class Epi, class Sched, bool ALIGN_EPI = false, bool SP2 = false>
__device__ __forceinline__ void gemm_phase(PG8_LAS unsigned char* lds, const Gemm g, const Sched& S, const Epi& E) {
    const int tid = threadIdx.x, wid = __builtin_amdgcn_readfirstlane(tid >> 6), lane = tid & 63, wr = wid >> 2, wc = wid & 3, fr = lane & 15, fq = lane >> 4;
    const int K = g.K, nt = K / BK;
    unsigned voffA[2], voffB[2];
#pragma unroll
    for (int i = 0; i < 2; ++i) { int R, C; stage_rc(tid * 16 + i * 8192, R, C); const int Rb = Epi::PERM ? ((R & ~31) + perm32(R & 31)) : R;
        voffA[i] = (unsigned)(R * K + C) * 2u; voffB[i] = (unsigned)(Rb * K + C) * 2u; }
    const size_t kstep = (size_t)(BK * 2);
    const size_t hstep = (size_t)HALF * K * 2;
    const size_t tstep = 2 * hstep;
    const unsigned ldsw = (unsigned)wid * 1024u;
    const int aoff = lds_byte(wr * 64 + fr, fq * 8), boff = lds_byte(wc * 32 + fr, fq * 8);
#define PG8_SA(b, h) (((b) * 2 + (h)) * HTB)
#define PG8_SB(b, h) ((4 + (b) * 2 + (h)) * HTB)
#define PG8_STAGE(bufoff, gbase, voff) do { _Pragma("unroll") for (int _i = 0; _i < 2; ++_i) \
        __builtin_amdgcn_global_load_lds((const unsigned*)((const char*)(gbase) + (voff)[_i]), (PG8_LAS unsigned*)(lds + (bufoff) + ldsw + _i * 8192), 16, 0, 0); } while (0)
#define PG8_LDA(dst, b, h) do { _Pragma("unroll") for (int m = 0; m < 4; ++m) _Pragma("unroll") for (int k = 0; k < 2; ++k) dst[m][k] = *(const PG8_LAS bf16x8*)(lds + PG8_SA(b, h) + aoff + m * 2048 + k * 1024); } while (0)
#define PG8_LDB(dst, b, h) do { _Pragma("unroll") for (int n = 0; n < 2; ++n) _Pragma("unroll") for (int k = 0; k < 2; ++k) dst[n][k] = *(const PG8_LAS bf16x8*)(lds + PG8_SB(b, h) + boff + n * 2048 + k * 1024); } while (0)
#define PG8_MMA(ai, bj, At, Bt) do { __builtin_amdgcn_s_setprio(1); _Pragma("unroll") for (int m = 0; m < 4; ++m) _Pragma("unroll") for (int n = 0; n < 2; ++n) _Pragma("unroll") for (int k = 0; k < 2; ++k) \
        acc[ai][bj][m][n] = __builtin_amdgcn_mfma_f32_16x16x32_bf16(Bt[n][k], At[m][k], acc[ai][bj][m][n], 0, 0, 0); __builtin_amdgcn_s_setprio(0); } while (0)
#define PG8_WAIT_V(n) asm volatile("s_waitcnt vmcnt(" #n ")" ::: "memory")
#define PG8_WAIT_L(n) asm volatile("s_waitcnt lgkmcnt(" #n ")" ::: "memory")
#define PG8_BAR __builtin_amdgcn_s_barrier()
#define PG8_SCHED __builtin_amdgcn_sched_barrier(0)
    Unit cur, nxt; int ui = 0;
    if (!S.next(0, cur)) return;
    f32x4 acc[2][2][4][2];
#pragma unroll
    for (int a = 0; a < 2; ++a)
#pragma unroll
        for (int b = 0; b < 2; ++b)
#pragma unroll
            for (int m = 0; m < 4; ++m)
#pragma unroll
                for (int n = 0; n < 2; ++n) acc[a][b][m][n] = (f32x4){0.f, 0.f, 0.f, 0.f};
    bf16x8 At[4][2], B0[2][2], B1[2][2];
    const char* cA = (const char*)g.A + (size_t)cur.pm * tstep; const char* cB = (const char*)g.Bt + (size_t)cur.pn * tstep;
    S.a_ready(cur);
    if constexpr (SP2) {
        PG8_STAGE(PG8_SB(0, 0), cB, voffB); PG8_STAGE(PG8_SB(0, 1), cB + hstep, voffB); PG8_STAGE(PG8_SA(0, 0), cA, voffA); PG8_STAGE(PG8_SA(0, 1), cA + hstep, voffA);
        if (wr == 1) PG8_BAR;
        PG8_WAIT_V(2); PG8_BAR;
        PG8_STAGE(PG8_SB(1, 0), cB + kstep, voffB); PG8_STAGE(PG8_SA(1, 0), cA + kstep, voffA); PG8_STAGE(PG8_SB(1, 1), cB + hstep + kstep, voffB);
        PG8_WAIT_V(6); PG8_BAR;
    } else {
        PG8_STAGE(PG8_SB(0, 0), cB, voffB); PG8_STAGE(PG8_SA(0, 0), cA, voffA); PG8_STAGE(PG8_SB(0, 1), cB + hstep, voffB); PG8_STAGE(PG8_SA(0, 1), cA + hstep, voffA);
        if (wr == 1) PG8_BAR;
        PG8_WAIT_V(4); PG8_BAR;
        PG8_STAGE(PG8_SB(1, 0), cB + kstep, voffB); PG8_STAGE(PG8_SA(1, 0), cA + kstep, voffA); PG8_STAGE(PG8_SB(1, 1), cB + hstep + kstep, voffB);
        PG8_WAIT_V(6); PG8_BAR;
    }
    for (;;) {
        const bool has_next = S.next(ui + 1, nxt);
        const char* nA = has_next ? (const char*)g.A + (size_t)nxt.pm * tstep : cA; const char* nB = has_next ? (const char*)g.Bt + (size_t)nxt.pn * tstep : cB;
        for (int t = 0; t < nt; t += 2) {
            const bool last = (t == nt - 2);
            const char* a1 = cA + (size_t)(t + 1) * kstep;
            const char* a2 = last ? nA : cA + (size_t)(t + 2) * kstep; const char* b2 = last ? nB : cB + (size_t)(t + 2) * kstep;
            const char* a3 = a2 + kstep; const char* b3 = b2 + kstep;
            if (last && has_next) S.a_ready(nxt);
            if constexpr (SP2) {
            PG8_LDB(B0, 0, 0); PG8_LDB(B1, 0, 1); PG8_SCHED; PG8_LDA(At, 0, 0); PG8_STAGE(PG8_SA(1, 1), a1 + hstep, voffA);
            PG8_WAIT_V(8); PG8_WAIT_L(0); PG8_BAR; PG8_MMA(0, 0, At, B0); PG8_MMA(0, 1, At, B1); PG8_BAR; PG8_SCHED;
            PG8_LDA(At, 0, 1); PG8_STAGE(PG8_SB(0, 0), b2, voffB); PG8_STAGE(PG8_SB(0, 1), b2 + hstep, voffB); PG8_STAGE(PG8_SA(0, 0), a2, voffA);
            PG8_WAIT_V(8); PG8_WAIT_L(0); PG8_BAR; PG8_MMA(1, 0, At, B0); PG8_MMA(1, 1, At, B1); PG8_BAR; PG8_SCHED;
            PG8_LDB(B0, 1, 0); PG8_LDB(B1, 1, 1); PG8_SCHED; PG8_LDA(At, 1, 0); PG8_STAGE(PG8_SA(0, 1), a2 + hstep, voffA);
            PG8_WAIT_V(8); PG8_WAIT_L(0); PG8_BAR; PG8_MMA(0, 0, At, B0); PG8_MMA(0, 1, At, B1); PG8_BAR; PG8_SCHED;
            PG8_LDA(At, 1, 1); PG8_STAGE(PG8_SB(1, 0), b3, voffB); PG8_STAGE(PG8_SB(1, 1), b3 + hstep, voffB); PG8_STAGE(PG8_SA(1, 0), a3, voffA);
            PG8_WAIT_V(8); PG8_WAIT_L(0); PG8_BAR; PG8_MMA(1, 0, At, B0); PG8_MMA(1, 1, At, B1); PG8_BAR; PG8_SCHED;
            } else {
            PG8_LDB(B0, 0, 0); PG8_SCHED; PG8_LDA(At, 0, 0); PG8_STAGE(PG8_SA(1, 1), a1 + hstep, voffA);
            PG8_WAIT_L(8); PG8_BAR; PG8_WAIT_L(0); PG8_MMA(0, 0, At, B0); PG8_BAR; PG8_SCHED;
            PG8_LDB(B1, 0, 1); PG8_STAGE(PG8_SB(0, 0), b2, voffB);
            PG8_BAR; PG8_WAIT_L(0); PG8_MMA(0, 1, At, B1); PG8_BAR;
            PG8_LDA(At, 0, 1); PG8_STAGE(PG8_SA(0, 0), a2, voffA);
            PG8_BAR; PG8_WAIT_L(0); PG8_MMA(1, 0, At, B0); PG8_BAR; PG8_SCHED;
            PG8_STAGE(PG8_SB(0, 1), b2 + hstep, voffB);
            PG8_WAIT_V(6); PG8_BAR; PG8_MMA(1, 1, At, B1); PG8_BAR;
            PG8_LDB(B0, 1, 0); PG8_SCHED; PG8_LDA(At, 1, 0); PG8_STAGE(PG8_SA(0, 1), a2 + hstep, voffA);
            PG8_WAIT_L(8); PG8_BAR; PG8_WAIT_L(0); PG8_MMA(0, 0, At, B0); PG8_BAR; PG8_SCHED;
            PG8_LDB(B1, 1, 1); PG8_STAGE(PG8_SB(1, 0), b3, voffB);
            PG8_BAR; PG8_WAIT_L(0); PG8_MMA(0, 1, At, B1); PG8_BAR;
            PG8_LDA(At, 1, 1); PG8_STAGE(PG8_SA(1, 0), a3, voffA);
            PG8_BAR; PG8_WAIT_L(0); PG8_MMA(1, 0, At, B0); PG8_BAR; PG8_SCHED;
            PG8_STAGE(PG8_SB(1, 1), b3 + hstep, voffB);
            PG8_WAIT_V(6); PG8_BAR; PG8_MMA(1, 1, At, B1); PG8_BAR;
            }
        }
        if constexpr (ALIGN_EPI) { if (wr == 0) PG8_BAR; }
        if constexpr (!Epi::AFTER_DRAIN) { E(acc, cur, wr, wc, fr, fq); S.done(cur); }
        if (!has_next) break;
#pragma unroll
        for (int a = 0; a < 2; ++a)
#pragma unroll
            for (int b = 0; b < 2; ++b)
#pragma unroll
                for (int m = 0; m < 4; ++m)
#pragma unroll
                    for (int n = 0; n < 2; ++n) acc[a][b][m][n] = (f32x4){0.f, 0.f, 0.f, 0.f};
        cur = nxt; cA = nA; cB = nB; ++ui;
        if constexpr (ALIGN_EPI) { if (wr == 1) PG8_BAR; }
    }
    PG8_WAIT_V(0);
    if constexpr (!ALIGN_EPI) { if (wr == 0) PG8_BAR; }
    PG8_BAR;
    if constexpr (Epi::AFTER_DRAIN) { E.fused(acc, cur, wr, wc, fr, fq, lds, wid, lane); S.done(cur); }
#undef PG8_SA
#undef PG8_SB
#undef PG8_STAGE
#undef PG8_LDA
#undef PG8_LDB
#undef PG8_MMA
#undef PG8_WAIT_V
#undef PG8_WAIT_L
#undef PG8_BAR
#undef PG8_SCHED
}
template <class Epi, class Sched, bool ALIGN_EPI = false, bool SP2 = false>
__device__ __forceinline__ void gemm_phase_dual(PG8_LAS unsigned char* lds, const Gemm g, const Gemm g1, const Sched& S, const Epi& E) {
    const int tid = threadIdx.x, wid = __builtin_amdgcn_readfirstlane(tid >> 6), lane = tid & 63, wr = wid >> 2, wc = wid & 3, fr = lane & 15, fq = lane >> 4;
    const int K = g.K, nt = K / BK;
    unsigned voffA[2], voffB[2];
#pragma unroll
    for (int i = 0; i < 2; ++i) { int R, C; stage_rc(tid * 16 + i * 8192, R, C); const int Rb = Epi::PERM ? ((R & ~31) + perm32(R & 31)) : R;
        voffA[i] = (unsigned)(R * K + C) * 2u; voffB[i] = (unsigned)(Rb * K + C) * 2u; }
    const size_t kstep = (size_t)(BK * 2);
    const size_t hstep = (size_t)HALF * K * 2;
    const size_t tstep = 2 * hstep;
    const unsigned ldsw = (unsigned)wid * 1024u;
    const int aoff = lds_byte(wr * 64 + fr, fq * 8), boff = lds_byte(wc * 32 + fr, fq * 8);
#define PG8_SA(b, h) (((b) * 2 + (h)) * HTB)
#define PG8_SB(b, h) ((4 + (b) * 2 + (h)) * HTB)
#define PG8_STAGE(bufoff, gbase, voff) do { _Pragma("unroll") for (int _i = 0; _i < 2; ++_i) \
        __builtin_amdgcn_global_load_lds((const unsigned*)((const char*)(gbase) + (voff)[_i]), (PG8_LAS unsigned*)(lds + (bufoff) + ldsw + _i * 8192), 16, 0, 0); } while (0)
#define PG8_LDA(dst, b, h) do { _Pragma("unroll") for (int m = 0; m < 4; ++m) _Pragma("unroll") for (int k = 0; k < 2; ++k) dst[m][k] = *(const PG8_LAS bf16x8*)(lds + PG8_SA(b, h) + aoff + m * 2048 + k * 1024); } while (0)
#define PG8_LDB(dst, b, h) do { _Pragma("unroll") for (int n = 0; n < 2; ++n) _Pragma("unroll") for (int k = 0; k < 2; ++k) dst[n][k] = *(const PG8_LAS bf16x8*)(lds + PG8_SB(b, h) + boff + n * 2048 + k * 1024); } while (0)
#define PG8_MMA(ai, bj, At, Bt) do { __builtin_amdgcn_s_setprio(1); _Pragma("unroll") for (int m = 0; m < 4; ++m) _Pragma("unroll") for (int n = 0; n < 2; ++n) _Pragma("unroll") for (int k = 0; k < 2; ++k) \
        acc[ai][bj][m][n] = __builtin_amdgcn_mfma_f32_16x16x32_bf16(Bt[n][k], At[m][k], acc[ai][bj][m][n], 0, 0, 0); __builtin_amdgcn_s_setprio(0); } while (0)
#define PG8_WAIT_V(n) asm volatile("s_waitcnt vmcnt(" #n ")" ::: "memory")
#define PG8_WAIT_L(n) asm volatile("s_waitcnt lgkmcnt(" #n ")" ::: "memory")
#define PG8_BAR __builtin_amdgcn_s_barrier()
#define PG8_SCHED __builtin_amdgcn_sched_barrier(0)
    Unit cur, nxt; int ui = 0;
    if (!S.next(0, cur)) return;
    f32x4 acc[2][2][4][2];
#pragma unroll
    for (int a = 0; a < 2; ++a)
#pragma unroll
        for (int b = 0; b < 2; ++b)
#pragma unroll
            for (int m = 0; m < 4; ++m)
#pragma unroll
                for (int n = 0; n < 2; ++n) acc[a][b][m][n] = (f32x4){0.f, 0.f, 0.f, 0.f};
    bf16x8 At[4][2], B0[2][2], B1[2][2];
    const char* cA = (const char*)((cur.pn >> 16) ? g1.A : g.A) + (size_t)cur.pm * tstep; const char* cB = (const char*)((cur.pn >> 16) ? g1.Bt : g.Bt) + (size_t)(cur.pn & 0xffff) * tstep;
    S.a_ready(cur);
    if constexpr (SP2) {
        PG8_STAGE(PG8_SB(0, 0), cB, voffB); PG8_STAGE(PG8_SB(0, 1), cB + hstep, voffB); PG8_STAGE(PG8_SA(0, 0), cA, voffA); PG8_STAGE(PG8_SA(0, 1), cA + hstep, voffA);
        if (wr == 1) PG8_BAR;
        PG8_WAIT_V(2); PG8_BAR;
        PG8_STAGE(PG8_SB(1, 0), cB + kstep, voffB); PG8_STAGE(PG8_SA(1, 0), cA + kstep, voffA); PG8_STAGE(PG8_SB(1, 1), cB + hstep + kstep, voffB);
        PG8_WAIT_V(6); PG8_BAR;
    } else {
        PG8_STAGE(PG8_SB(0, 0), cB, voffB); PG8_STAGE(PG8_SA(0, 0), cA, voffA); PG8_STAGE(PG8_SB(0, 1), cB + hstep, voffB); PG8_STAGE(PG8_SA(0, 1), cA + hstep, voffA);
        if (wr == 1) PG8_BAR;
        PG8_WAIT_V(4); PG8_BAR;
        PG8_STAGE(PG8_SB(1, 0), cB + kstep, voffB); PG8_STAGE(PG8_SA(1, 0), cA + kstep, voffA); PG8_STAGE(PG8_SB(1, 1), cB + hstep + kstep, voffB);
        PG8_WAIT_V(6); PG8_BAR;
    }
    for (;;) {
        const bool has_next = S.next(ui + 1, nxt);
        const char* nA = has_next ? (const char*)((nxt.pn >> 16) ? g1.A : g.A) + (size_t)nxt.pm * tstep : cA; const char* nB = has_next ? (const char*)((nxt.pn >> 16) ? g1.Bt : g.Bt) + (size_t)(nxt.pn & 0xffff) * tstep : cB;
        for (int t = 0; t < nt; t += 2) {
            const bool last = (t == nt - 2);
            const char* a1 = cA + (size_t)(t + 1) * kstep;
            const char* a2 = last ? nA : cA + (size_t)(t + 2) * kstep; const char* b2 = last ? nB : cB + (size_t)(t + 2) * kstep;
            const char* a3 = a2 + kstep; const char* b3 = b2 + kstep;
            if (last && has_next) S.a_ready(nxt);
            if constexpr (SP2) {
            PG8_LDB(B0, 0, 0); PG8_LDB(B1, 0, 1); PG8_SCHED; PG8_LDA(At, 0, 0); PG8_STAGE(PG8_SA(1, 1), a1 + hstep, voffA);
            PG8_WAIT_V(8); PG8_WAIT_L(0); PG8_BAR; PG8_MMA(0, 0, At, B0); PG8_MMA(0, 1, At, B1); PG8_BAR; PG8_SCHED;
            PG8_LDA(At, 0, 1); PG8_STAGE(PG8_SB(0, 0), b2, voffB); PG8_STAGE(PG8_SB(0, 1), b2 + hstep, voffB); PG8_STAGE(PG8_SA(0, 0), a2, voffA);
            PG8_WAIT_V(8); PG8_WAIT_L(0); PG8_BAR; PG8_MMA(1, 0, At, B0); PG8_MMA(1, 1, At, B1); PG8_BAR; PG8_SCHED;
            PG8_LDB(B0, 1, 0); PG8_LDB(B1, 1, 1); PG8_SCHED; PG8_LDA(At, 1, 0); PG8_STAGE(PG8_SA(0, 1), a2 + hstep, voffA);
            PG8_WAIT_V(8); PG8_WAIT_L(0); PG8_BAR; PG8_MMA(0, 0, At, B0); PG8_MMA(0, 1, At, B1); PG8_BAR; PG8_SCHED;
            PG8_LDA(At, 1, 1); PG8_STAGE(PG8_SB(1, 0), b3, voffB); PG8_STAGE(PG8_SB(1, 1), b3 + hstep, voffB); PG8_STAGE(PG8_SA(1, 0), a3, voffA);
            PG8_WAIT_V(8); PG8_WAIT_L(0); PG8_BAR; PG8_MMA(1, 0, At, B0); PG8_MMA(1, 1, At, B1); PG8_BAR; PG8_SCHED;
            } else {
            PG8_LDB(B0, 0, 0); PG8_SCHED; PG8_LDA(At, 0, 0); PG8_STAGE(PG8_SA(1, 1), a1 + hstep, voffA);
            PG8_WAIT_L(8); PG8_BAR; PG8_WAIT_L(0); PG8_MMA(0, 0, At, B0); PG8_BAR; PG8_SCHED;
            PG8_LDB(B1, 0, 1); PG8_STAGE(PG8_SB(0, 0), b2, voffB);
            PG8_BAR; PG8_WAIT_L(0); PG8_MMA(0, 1, At, B1); PG8_BAR;
            PG8_LDA(At, 0, 1); PG8_STAGE(PG8_SA(0, 0), a2, voffA);
            PG8_BAR; PG8_WAIT_L(0); PG8_MMA(1, 0, At, B0); PG8_BAR; PG8_SCHED;
            PG8_STAGE(PG8_SB(0, 1), b2 + hstep, voffB);
            PG8_WAIT_V(6); PG8_BAR; PG8_MMA(1, 1, At, B1); PG8_BAR;
            PG8_LDB(B0, 1, 0); PG8_SCHED; PG8_LDA(At, 1, 0); PG8_STAGE(PG8_SA(0, 1), a2 + hstep, voffA);
            PG8_WAIT_L(8); PG8_BAR; PG8_WAIT_L(0); PG8_MMA(0, 0, At, B0); PG8_BAR; PG8_SCHED;
            PG8_LDB(B1, 1, 1); PG8_STAGE(PG8_SB(1, 0), b3, voffB);
            PG8_BAR; PG8_WAIT_L(0); PG8_MMA(0, 1, At, B1); PG8_BAR;
            PG8_LDA(At, 1, 1); PG8_STAGE(PG8_SA(1, 0), a3, voffA);
            PG8_BAR; PG8_WAIT_L(0); PG8_MMA(1, 0, At, B0); PG8_BAR; PG8_SCHED;
            PG8_STAGE(PG8_SB(1, 1), b3 + hstep, voffB);
            PG8_WAIT_V(6); PG8_BAR; PG8_MMA(1, 1, At, B1); PG8_BAR;
            }
        }
        if constexpr (ALIGN_EPI) { if (wr == 0) PG8_BAR; }
        if constexpr (!Epi::AFTER_DRAIN) { E(acc, cur, wr, wc, fr, fq); S.done(cur); }
        if (!has_next) break;
        if (cur.pn >> 16)
#pragma unroll
        for (int a = 0; a < 2; ++a)
#pragma unroll
            for (int b = 0; b < 2; ++b)
#pragma unroll
                for (int m = 0; m < 4; ++m)
#pragma unroll
                    for (int n = 0; n < 2; ++n) acc[a][b][m][n] = (f32x4){0.f, 0.f, 0.f, 0.f};
        cur = nxt; cA = nA; cB = nB; ++ui;
        if constexpr (ALIGN_EPI) { if (wr == 1) PG8_BAR; }
    }
    PG8_WAIT_V(0);
    if constexpr (!ALIGN_EPI) { if (wr == 0) PG8_BAR; }
    PG8_BAR;
    if constexpr (Epi::AFTER_DRAIN) { E.fused(acc, cur, wr, wc, fr, fq, lds, wid, lane); S.done(cur); }
#undef PG8_SA
#undef PG8_SB
#undef PG8_STAGE
#undef PG8_LDA
#undef PG8_LDB
#undef PG8_MMA
#undef PG8_WAIT_V
#undef PG8_WAIT_L
#undef PG8_BAR
#undef PG8_SCHED
}
}

namespace ep {
using pg8::f32x4; using pg8::u32x4; using pg8::Unit; using pg8::bf16_t; using pg8::BM; using pg8::HALF; using pg8::cvt_pk_bf16;
typedef float f32x2 __attribute__((ext_vector_type(2)));
__device__ __forceinline__ float bf_lo(unsigned w) { return __uint_as_float(w << 16); }
__device__ __forceinline__ float bf_hi(unsigned w) { return __uint_as_float(w & 0xffff0000u); }
__device__ __forceinline__ float sigm(float x) { return __builtin_amdgcn_rcpf(1.0f + __expf(-x)); }
#define EP_ACC const f32x4 (&acc)[2][2][4][2], const Unit& u, int wr, int wc, int fr, int fq

struct EpiPlain { static constexpr bool PERM = true, AFTER_DRAIN = false; bf16_t* O; int ldc;
    __device__ __forceinline__ void operator()(EP_ACC) const {
        const int row0 = u.pm * BM + wr * 64 + fr, col0 = u.pn * BM + wc * 32 + 8 * fq;
#pragma unroll
        for (int ai = 0; ai < 2; ++ai)
#pragma unroll
            for (int m = 0; m < 4; ++m) { bf16_t* rowp = O + (size_t)(row0 + ai * HALF + m * 16) * ldc + col0;
#pragma unroll
                for (int bj = 0; bj < 2; ++bj) { const f32x4 v0 = acc[ai][bj][m][0], v1 = acc[ai][bj][m][1];
                    u32x4 w; w.x = cvt_pk_bf16(v0[0], v0[1]); w.y = cvt_pk_bf16(v0[2], v0[3]); w.z = cvt_pk_bf16(v1[0], v1[1]); w.w = cvt_pk_bf16(v1[2], v1[3]);
                    *(u32x4*)(rowp + bj * HALF) = w; } }
    }
};
struct EpiQKG { static constexpr bool PERM = true, AFTER_DRAIN = false; bf16_t* O; const f32x2* rope;
    __device__ __forceinline__ void operator()(EP_ACC) const {
        const int row0 = u.pm * BM + wr * 64 + fr, col0 = u.pn * BM + wc * 32 + 8 * fq;
        const bool isk = (u.pn == 2) || (u.pn == 3);
        const int jg = (wc & 1) * 4 + fq, i0 = (jg & 3) * 4;
#pragma unroll
        for (int ai = 0; ai < 2; ++ai)
#pragma unroll
            for (int m = 0; m < 4; ++m) { const int row = row0 + ai * HALF + m * 16; bf16_t* rowp = O + (size_t)row * 3072 + col0;
                const int t = row & 4095, pos = (jg & 4) ? (t & 63) : (t >> 6);
                f32x2 cs[4];
                if (isk) {
#pragma unroll
                    for (int e = 0; e < 4; ++e) cs[e] = rope[pos * 16 + i0 + e];
                }
#pragma unroll
                for (int bj = 0; bj < 2; ++bj) { f32x4 v0 = acc[ai][bj][m][0], v1 = acc[ai][bj][m][1];
                    if (isk) {
#pragma unroll
                        for (int e = 0; e < 4; ++e) { const float x1 = v0[e], x2 = v1[e]; v0[e] = x1 * cs[e].x - x2 * cs[e].y; v1[e] = x2 * cs[e].x + x1 * cs[e].y; }
                    }
                    u32x4 w; w.x = cvt_pk_bf16(v0[0], v0[1]); w.y = cvt_pk_bf16(v0[2], v0[3]); w.z = cvt_pk_bf16(v1[0], v1[1]); w.w = cvt_pk_bf16(v1[2], v1[3]);
                    *(u32x4*)(rowp + bj * HALF) = w; } }
    }
};
struct EpiGateNA { static constexpr bool PERM = true, AFTER_DRAIN = false; float* M1; const bf16_t* G;
    __device__ __forceinline__ void operator()(EP_ACC) const {
        const int row0 = u.pm * BM + wr * 64 + fr, col0 = u.pn * BM + wc * 32 + 8 * fq;
#pragma unroll
        for (int ai = 0; ai < 2; ++ai)
#pragma unroll
            for (int m = 0; m < 4; ++m) { const size_t row = (size_t)(row0 + ai * HALF + m * 16);
#pragma unroll
                for (int bj = 0; bj < 2; ++bj) { const int col = col0 + bj * HALF; const f32x4 v0 = acc[ai][bj][m][0], v1 = acc[ai][bj][m][1];
                    const u32x4 gw = *(const u32x4*)(G + row * 3072 + 1024 + col);
                    f32x4 o0, o1;
                    o0[0] = sigm(bf_lo(gw.x)) * v0[0]; o0[1] = sigm(bf_hi(gw.x)) * v0[1]; o0[2] = sigm(bf_lo(gw.y)) * v0[2]; o0[3] = sigm(bf_hi(gw.y)) * v0[3];
                    o1[0] = sigm(bf_lo(gw.z)) * v1[0]; o1[1] = sigm(bf_hi(gw.z)) * v1[1]; o1[2] = sigm(bf_lo(gw.w)) * v1[2]; o1[3] = sigm(bf_hi(gw.w)) * v1[3];
                    float* op = M1 + row * 1024 + col; *(f32x4*)op = o0; *(f32x4*)(op + 4) = o1; } }
    }
};
struct EpiGateHY { static constexpr bool PERM = true, AFTER_DRAIN = false; const float* M1; const bf16_t* G; bf16_t* MB;
    __device__ __forceinline__ void operator()(EP_ACC) const {
        const int row0 = u.pm * BM + wr * 64 + fr, col0 = u.pn * BM + wc * 32 + 8 * fq;
#pragma unroll
        for (int ai = 0; ai < 2; ++ai)
#pragma unroll
            for (int m = 0; m < 4; ++m) { const size_t row = (size_t)(row0 + ai * HALF + m * 16);
#pragma unroll
                for (int bj = 0; bj < 2; ++bj) { const int col = col0 + bj * HALF; const f32x4 v0 = acc[ai][bj][m][0], v1 = acc[ai][bj][m][1];
                    const u32x4 gw = *(const u32x4*)(G + row * 3072 + 2048 + col);
                    const float* ip = M1 + row * 1024 + col; const f32x4 a0 = *(const f32x4*)ip, a1 = *(const f32x4*)(ip + 4);
                    f32x4 o0, o1;
                    o0[0] = a0[0] + sigm(bf_lo(gw.x)) * v0[0]; o0[1] = a0[1] + sigm(bf_hi(gw.x)) * v0[1]; o0[2] = a0[2] + sigm(bf_lo(gw.y)) * v0[2]; o0[3] = a0[3] + sigm(bf_hi(gw.y)) * v0[3];
                    o1[0] = a1[0] + sigm(bf_lo(gw.z)) * v1[0]; o1[1] = a1[1] + sigm(bf_hi(gw.z)) * v1[1]; o1[2] = a1[2] + sigm(bf_lo(gw.w)) * v1[2]; o1[3] = a1[3] + sigm(bf_hi(gw.w)) * v1[3];
                    u32x4 w; w.x = cvt_pk_bf16(o0[0], o0[1]); w.y = cvt_pk_bf16(o0[2], o0[3]); w.z = cvt_pk_bf16(o1[0], o1[1]); w.w = cvt_pk_bf16(o1[2], o1[3]);
                    *(u32x4*)(MB + row * 1024 + col) = w; } }
    }
};
struct EpiRes1 { static constexpr bool PERM = true, AFTER_DRAIN = false; const float* x; bf16_t* X1B; const float* mod; const float* n2g; bf16_t* A2; unsigned long long* rowss;
    __device__ __forceinline__ void operator()(EP_ACC) const {
        const int row0 = u.pm * BM + wr * 64 + fr, col0 = u.pn * BM + wc * 32 + 8 * fq;
        const float* mb = mod + (size_t)((u.pm * BM) >> 12) * 6144;
        float ss[2][4];
#pragma unroll
        for (int ai = 0; ai < 2; ++ai)
#pragma unroll
            for (int m = 0; m < 4; ++m) ss[ai][m] = 0.f;
#pragma unroll
        for (int bj = 0; bj < 2; ++bj) { const int col = col0 + bj * HALF;
            const f32x4 gv0 = *(const f32x4*)(mb + 2048 + col), gv1 = *(const f32x4*)(mb + 2048 + col + 4);
            const f32x4 gs0 = *(const f32x4*)(n2g + col) * (*(const f32x4*)(mb + 4096 + col) + 1.0f), gs1 = *(const f32x4*)(n2g + col + 4) * (*(const f32x4*)(mb + 4096 + col + 4) + 1.0f);
#pragma unroll
            for (int ai = 0; ai < 2; ++ai)
#pragma unroll
                for (int m = 0; m < 4; ++m) { const size_t off = (size_t)(row0 + ai * HALF + m * 16) * 1024 + col;
                    const f32x4 a0 = __builtin_nontemporal_load((const f32x4*)(x + off)) + gv0 * acc[ai][bj][m][0], a1 = __builtin_nontemporal_load((const f32x4*)(x + off + 4)) + gv1 * acc[ai][bj][m][1];
                    { u32x4 wx; wx.x = cvt_pk_bf16(a0[0], a0[1]); wx.y = cvt_pk_bf16(a0[2], a0[3]); wx.z = cvt_pk_bf16(a1[0], a1[1]); wx.w = cvt_pk_bf16(a1[2], a1[3]); *(u32x4*)(X1B + off) = wx; }
                    ss[ai][m] += ((a0[0] * a0[0] + a0[1] * a0[1]) + (a0[2] * a0[2] + a0[3] * a0[3])) + ((a1[0] * a1[0] + a1[1] * a1[1]) + (a1[2] * a1[2] + a1[3] * a1[3]));
                    const f32x4 s0 = a0 * gs0, s1 = a1 * gs1;
                    u32x4 w; w.x = cvt_pk_bf16(s0[0], s0[1]); w.y = cvt_pk_bf16(s0[2], s0[3]); w.z = cvt_pk_bf16(s1[0], s1[1]); w.w = cvt_pk_bf16(s1[2], s1[3]);
                    *(u32x4*)(A2 + off) = w; } }
#pragma unroll
        for (int ai = 0; ai < 2; ++ai)
#pragma unroll
            for (int m = 0; m < 4; ++m) { float t = ss[ai][m]; t += __shfl_xor(t, 16); t += __shfl_xor(t, 32);
                if (fq == 0) atomicAdd(rowss + row0 + ai * HALF + m * 16, (unsigned long long)(t * 1048576.0f + 0.5f)); }
    }
};
struct EpiRes2 { static constexpr bool PERM = true, AFTER_DRAIN = false; float* out; const float* mod; unsigned long long* rowss; const bf16_t* X1B;
    __device__ __forceinline__ void operator()(EP_ACC) const {
        const int row0 = u.pm * BM + wr * 64 + fr, col0 = u.pn * BM + wc * 32 + 8 * fq;
        const float* mb = mod + (size_t)((u.pm * BM) >> 12) * 6144;
        float ss[2][4];
#pragma unroll
        for (int ai = 0; ai < 2; ++ai)
#pragma unroll
            for (int m = 0; m < 4; ++m) ss[ai][m] = 0.f;
#pragma unroll
        for (int bj = 0; bj < 2; ++bj) { const int col = col0 + bj * HALF;
            const f32x4 gv0 = *(const f32x4*)(mb + 5120 + col), gv1 = *(const f32x4*)(mb + 5120 + col + 4);
#pragma unroll
            for (int ai = 0; ai < 2; ++ai)
#pragma unroll
                for (int m = 0; m < 4; ++m) { const size_t off = (size_t)(row0 + ai * HALF + m * 16) * 1024 + col;
                    const u32x4 xb = __builtin_nontemporal_load((const u32x4*)(X1B + off));
                    f32x4 x0, x1; x0[0] = bf_lo(xb.x); x0[1] = bf_hi(xb.x); x0[2] = bf_lo(xb.y); x0[3] = bf_hi(xb.y); x1[0] = bf_lo(xb.z); x1[1] = bf_hi(xb.z); x1[2] = bf_lo(xb.w); x1[3] = bf_hi(xb.w);
                    const f32x4 a0 = x0 + gv0 * acc[ai][bj][m][0], a1 = x1 + gv1 * acc[ai][bj][m][1];
                    *(f32x4*)(out + off) = a0; *(f32x4*)(out + off + 4) = a1;
                    ss[ai][m] += ((a0[0] * a0[0] + a0[1] * a0[1]) + (a0[2] * a0[2] + a0[3] * a0[3])) + ((a1[0] * a1[0] + a1[1] * a1[1]) + (a1[2] * a1[2] + a1[3] * a1[3])); } }
#pragma unroll
        for (int ai = 0; ai < 2; ++ai)
#pragma unroll
            for (int m = 0; m < 4; ++m) { float t = ss[ai][m]; t += __shfl_xor(t, 16); t += __shfl_xor(t, 32);
                if (fq == 0) atomicAdd(rowss + row0 + ai * HALF + m * 16, (unsigned long long)(t * 1048576.0f + 0.5f)); }
    }
};
struct EpiFFN { static constexpr bool PERM = true, AFTER_DRAIN = false; bf16_t* HID; const unsigned long long* rowss; const float* sW;
    __device__ __forceinline__ void operator()(EP_ACC) const {
        const int row0 = u.pm * BM + wr * 64 + fr, col0 = u.pn * HALF + wc * 32 + 8 * fq;
        const float* sp = sW + (size_t)((u.pm * BM) >> 12) * 5632 + u.pn * BM + wc * 32 + 8 * fq;
        const f32x4 s1a = *(const f32x4*)sp, s1b = *(const f32x4*)(sp + 4), s3a = *(const f32x4*)(sp + HALF), s3b = *(const f32x4*)(sp + HALF + 4);
#pragma unroll
        for (int ai = 0; ai < 2; ++ai)
#pragma unroll
            for (int m = 0; m < 4; ++m) { const int row = row0 + ai * HALF + m * 16; bf16_t* rowp = HID + (size_t)row * 2816 + col0;
                const float rstd = __builtin_amdgcn_rsqf((float)rowss[row] * (1.0f / (1024.0f * 1048576.0f)) + 1e-6f);
                const f32x4 a0 = acc[ai][0][m][0] * rstd + s1a, a1 = acc[ai][0][m][1] * rstd + s1b, b0 = acc[ai][1][m][0] * rstd + s3a, b1 = acc[ai][1][m][1] * rstd + s3b;
                f32x4 o0, o1;
#pragma unroll
                for (int e = 0; e < 4; ++e) { o0[e] = a0[e] * sigm(a0[e]) * b0[e]; o1[e] = a1[e] * sigm(a1[e]) * b1[e]; }
                u32x4 w; w.x = cvt_pk_bf16(o0[0], o0[1]); w.y = cvt_pk_bf16(o0[2], o0[3]); w.z = cvt_pk_bf16(o1[0], o1[1]); w.w = cvt_pk_bf16(o1[2], o1[3]);
                *(u32x4*)rowp = w; }
    }
};
struct EpiGateDual { static constexpr bool PERM = true, AFTER_DRAIN = false; const bf16_t* G; bf16_t* MB;
    __device__ __forceinline__ void operator()(f32x4 (&acc)[2][2][4][2], const Unit& u, int wr, int wc, int fr, int fq) const {
        const int part = u.pn >> 16, pn = u.pn & 0xffff;
        const int row0 = u.pm * BM + wr * 64 + fr, col0 = pn * BM + wc * 32 + 8 * fq;
#pragma unroll
        for (int ai = 0; ai < 2; ++ai)
#pragma unroll
            for (int m = 0; m < 4; ++m) { const size_t row = (size_t)(row0 + ai * HALF + m * 16);
#pragma unroll
                for (int bj = 0; bj < 2; ++bj) { const int col = col0 + bj * HALF;
                    const u32x4 gh = *(const u32x4*)(G + row * 3072 + 2048 + col);
                    if (part == 0) { const u32x4 gn = __builtin_nontemporal_load((const u32x4*)(G + row * 3072 + 1024 + col));
                        f32x4 r0, r1;
                        r0[0] = (1.0f + __expf(-bf_lo(gh.x))) * __builtin_amdgcn_rcpf(1.0f + __expf(-bf_lo(gn.x))); r0[1] = (1.0f + __expf(-bf_hi(gh.x))) * __builtin_amdgcn_rcpf(1.0f + __expf(-bf_hi(gn.x)));
                        r0[2] = (1.0f + __expf(-bf_lo(gh.y))) * __builtin_amdgcn_rcpf(1.0f + __expf(-bf_lo(gn.y))); r0[3] = (1.0f + __expf(-bf_hi(gh.y))) * __builtin_amdgcn_rcpf(1.0f + __expf(-bf_hi(gn.y)));
                        r1[0] = (1.0f + __expf(-bf_lo(gh.z))) * __builtin_amdgcn_rcpf(1.0f + __expf(-bf_lo(gn.z))); r1[1] = (1.0f + __expf(-bf_hi(gh.z))) * __builtin_amdgcn_rcpf(1.0f + __expf(-bf_hi(gn.z)));
                        r1[2] = (1.0f + __expf(-bf_lo(gh.w))) * __builtin_amdgcn_rcpf(1.0f + __expf(-bf_lo(gn.w))); r1[3] = (1.0f + __expf(-bf_hi(gh.w))) * __builtin_amdgcn_rcpf(1.0f + __expf(-bf_hi(gn.w)));
                        acc[ai][bj][m][0] = acc[ai][bj][m][0] * r0; acc[ai][bj][m][1] = acc[ai][bj][m][1] * r1; }
                    else { const f32x4 v0 = acc[ai][bj][m][0], v1 = acc[ai][bj][m][1];
                        u32x4 w; w.x = cvt_pk_bf16(sigm(bf_lo(gh.x)) * v0[0], sigm(bf_hi(gh.x)) * v0[1]); w.y = cvt_pk_bf16(sigm(bf_lo(gh.y)) * v0[2], sigm(bf_hi(gh.y)) * v0[3]);
                        w.z = cvt_pk_bf16(sigm(bf_lo(gh.z)) * v1[0], sigm(bf_hi(gh.z)) * v1[1]); w.w = cvt_pk_bf16(sigm(bf_lo(gh.w)) * v1[2], sigm(bf_hi(gh.w)) * v1[3]);
                        *(u32x4*)(MB + row * 1024 + col) = w; } } }
    }
};
struct DualOrder { pg8::StaticOrder b;
    __device__ bool next(int i, Unit& u) const { if (!b.next(i >> 1, u)) return false; u.pn |= (i & 1) << 16; return true; }
    __device__ __forceinline__ void a_ready(const Unit&) const {}
    __device__ __forceinline__ void done(const Unit&) const {}
};
#undef EP_ACC
}

#define LAS __attribute__((address_space(3)))
typedef unsigned short bf16;
typedef short bf16x8 __attribute__((ext_vector_type(8)));
typedef short s16x4 __attribute__((ext_vector_type(4)));
typedef float f32x4 __attribute__((ext_vector_type(4)));
typedef float f32x2 __attribute__((ext_vector_type(2)));
typedef unsigned u32x4 __attribute__((ext_vector_type(4)));
typedef unsigned u32x2 __attribute__((ext_vector_type(2)));
constexpr int NW = 8, NT = 512;
constexpr int DM = 1024, MTOK = 32768, MCTX = 2048, MALL = MTOK + MCTX, FF = 2816, NMOD = 6144;
constexpr size_t MiB = (size_t)1 << 20;
constexpr size_t WS_WIN = 0, WS_WNAO = 10 * MiB, WS_WHYO = 11 * MiB, WS_WOUT = 12 * MiB, WS_W13 = 14 * MiB, WS_W2 = 25 * MiB;
constexpr size_t WS_MOD = 30 * MiB + 512 * 1024, WS_ROPE = 30 * MiB + 768 * 1024, WS_HID2 = 31 * MiB;
constexpr size_t WS_K2 = 32 * MiB;
constexpr size_t WS_H = 64 * MiB;
constexpr size_t WS_QKG = 132 * MiB;
constexpr size_t WS_YHT = 324 * MiB;
constexpr size_t WS_MB = 356 * MiB;
constexpr size_t WS_KC = 420 * MiB, WS_VCT = 422 * MiB;
constexpr size_t WS_Z1T = 424 * MiB;
constexpr size_t WS_RSS2 = 488 * MiB, WS_RSS3 = 488 * MiB + 256 * 1024;
constexpr size_t WS_SW = 488 * MiB + 512 * 1024;
constexpr size_t WS_CTL = 488 * MiB + 768 * 1024; constexpr int CTL_BYTES = 16384;
constexpr size_t WS_END = 489 * MiB;
constexpr int MISC_OFF = 2 * 8704 * 8;
constexpr int LDS_BYTES = 2 * 8704 * 8 + 1024;

#define XB_TMO      128
#define XB_XCNT(j)  (256  + 64 * (j))
#define XB_XSUB(j)  (1280 + 64 * (j))
#define XB_XGEN(j)  (2304 + 64 * (j))
#define XB_TOP      3328
#define XB_TOPGEN   3392
#define XCD_BAR_WORDS 3456
#define XB_SPIN_CAP (1u << 18)

__device__ __forceinline__ unsigned xb_ld(unsigned* p)              { return __hip_atomic_load(p, __ATOMIC_RELAXED, __HIP_MEMORY_SCOPE_AGENT); }
__device__ __forceinline__ unsigned xb_add(unsigned* p, unsigned v) { return __hip_atomic_fetch_add(p, v, __ATOMIC_RELAXED, __HIP_MEMORY_SCOPE_AGENT); }
__device__ __forceinline__ unsigned xb_xcc_id() { return (unsigned)__builtin_amdgcn_s_getreg((3 << 11) | 20) & 0xFu; }
#define XB_SPIN(cond, bar) do { unsigned _sp = 0; while (cond) { __builtin_amdgcn_s_sleep(1); \
    if ((++_sp & 255u) == 0u) { if (xb_ld(&(bar)[XB_TMO])) break; if (_sp > XB_SPIN_CAP) { atomicAdd(&(bar)[XB_TMO], 1u); break; } } } } while (0)

struct XcdBarrier {
    unsigned* bar; unsigned x;
    volatile LAS unsigned* st;
};

__device__ __forceinline__ XcdBarrier xcd_barrier_post(unsigned* bar, volatile LAS unsigned* st) {
    XcdBarrier b; b.bar = bar; b.x = xb_xcc_id(); b.st = st;
    if (threadIdx.x == 0) (void)xb_add(&bar[XB_XCNT(b.x)], 1u);
    return b;
}
__device__ __forceinline__ void xcd_barrier_complete(unsigned* bar, unsigned x, unsigned& nloc, unsigned& nx) {
    const unsigned G = gridDim.x * gridDim.y * gridDim.z;
    unsigned sum, cnt, mine, sp = 0u;
    for (;;) {
        sum = 0u; cnt = 0u; mine = 0u;
#pragma unroll
        for (unsigned j = 0; j < 16; ++j) { const unsigned c = xb_ld(&bar[XB_XCNT(j)]); sum += c; cnt += (c > 0u) ? 1u : 0u; mine = (j == x) ? c : mine; }
        if (sum == G) break;
        __builtin_amdgcn_s_sleep(1);
        if ((++sp & 255u) == 0u) { if (xb_ld(&bar[XB_TMO])) break; if (sp > XB_SPIN_CAP) { atomicAdd(&bar[XB_TMO], 1u); break; } }
    }
    nloc = mine > 0u ? mine : 1u; nx = cnt > 0u ? cnt : 1u;
}

__device__ __forceinline__ void xcd_barrier(const XcdBarrier& b) {
    asm volatile("s_waitcnt vmcnt(0)" ::: "memory");
    __syncthreads();
    if (threadIdx.x == 0) {
        unsigned* bar = b.bar;
        __builtin_amdgcn_s_waitcnt(0);
        unsigned nloc = b.st[0], nx = b.st[1];
        if (nloc == 0u) { xcd_barrier_complete(bar, b.x, nloc, nx); b.st[0] = nloc; b.st[1] = nx; }
        const unsigned old = xb_add(&bar[XB_XSUB(b.x)], 1u);
        const unsigned gen = old / nloc;
        if (old + 1u == (gen + 1u) * nloc) {
            __builtin_amdgcn_fence(__ATOMIC_RELEASE, "agent");
            asm volatile("s_waitcnt vmcnt(0)" ::: "memory");
            const unsigned og = xb_add(&bar[XB_TOP], 1u);
            const unsigned tg = og / nx;
            if (og + 1u == (tg + 1u) * nx) xb_add(&bar[XB_TOPGEN], 1u);
            else XB_SPIN(xb_ld(&bar[XB_TOPGEN]) == tg, bar);
            __builtin_amdgcn_fence(__ATOMIC_ACQUIRE, "agent");
            xb_add(&bar[XB_XGEN(b.x)], 1u);
            asm volatile("s_waitcnt vmcnt(0)" ::: "memory");
        } else {
            XB_SPIN(xb_ld(&bar[XB_XGEN(b.x)]) == gen, bar);
            __builtin_amdgcn_fence(__ATOMIC_ACQUIRE, "agent");
            asm volatile("s_waitcnt vmcnt(0)" ::: "memory");
        }
    }
    __syncthreads();
}

#define LDS_WAIT() asm volatile("s_waitcnt lgkmcnt(0)" ::: "memory")
__device__ __forceinline__ unsigned f2bf(float f) { unsigned u = __builtin_bit_cast(unsigned, f); return (u + 0x7fffu + ((u >> 16) & 1u)) >> 16; }
__device__ __forceinline__ unsigned pk2(float lo, float hi) { return f2bf(lo) | (f2bf(hi) << 16); }
__device__ __forceinline__ float bf2f(unsigned short s) { return __uint_as_float(((unsigned)s) << 16); }
__device__ __forceinline__ float wave_sum(float v) {
#pragma unroll
    for (int o = 1; o < 64; o <<= 1) v += __shfl_xor(v, o);
    return v;
}

__device__ __forceinline__ void tr_item(const float* W, int ldw, int srccol, bf16* WT, int K, int n0, int k0, LAS float* scr, int lane) {
    float tmp[32];
#pragma unroll
    for (int i = 0; i < 32; ++i) tmp[i] = __builtin_nontemporal_load(W + (size_t)(k0 + 2 * i + (lane >> 5)) * ldw + srccol);
#pragma unroll
    for (int i = 0; i < 32; ++i) scr[(2 * i + (lane >> 5)) * 33 + (lane & 31)] = tmp[i];
    LDS_WAIT(); asm volatile("" ::: "memory");
    const int c = lane & 7;
#pragma unroll
    for (int j = 0; j < 4; ++j) { const int n = (lane >> 3) + 8 * j; const LAS float* s = scr + (8 * c) * 33 + n;
        u32x4 o; o.x = pk2(s[0 * 33], s[1 * 33]); o.y = pk2(s[2 * 33], s[3 * 33]); o.z = pk2(s[4 * 33], s[5 * 33]); o.w = pk2(s[6 * 33], s[7 * 33]);
        *(u32x4*)(WT + (size_t)(n0 + n) * K + k0 + 8 * c) = o; }
    LDS_WAIT(); asm volatile("" ::: "memory");
}
__device__ __forceinline__ int mapcol_in(int n) {
    if (n < 1024) { const int base = n & 512, r = n & 511, h = r >> 6, s = r & 63, jg = s >> 3, e = s & 7;
        const int bs = (jg < 4) ? 4 * jg : 32 + 4 * (jg - 4); return base + h * 64 + bs + ((e < 4) ? e : 12 + e); }
    if (n < 3072) return 3072 + (n - 1024);
    return 1024 + (n - 3072);
}
__device__ __forceinline__ void norm_row(const float* xrow, bf16* orow, const float* g, const float* sh, const float* sc, int lane) {
    f32x4 v[4]; float s = 0.f;
#pragma unroll
    for (int j = 0; j < 4; ++j) { v[j] = *((const f32x4*)xrow + lane + 64 * j); s += (v[j].x * v[j].x + v[j].y * v[j].y) + (v[j].z * v[j].z + v[j].w * v[j].w); }
    const float rstd = 1.0f / sqrtf(wave_sum(s) * (1.f / 1024.f) + 1e-6f);
#pragma unroll
    for (int j = 0; j < 4; ++j) { const int k = 4 * (lane + 64 * j);
        const f32x4 gg = *(const f32x4*)(g + k), hh = *(const f32x4*)(sh + k), cc = *(const f32x4*)(sc + k);
        const f32x4 y = v[j] * rstd * gg * (cc + 1.0f) + hh;
        u32x2 w; w.x = pk2(y.x, y.y); w.y = pk2(y.z, y.w); *(u32x2*)(orow + k) = w; }
}

constexpr int XPAD = 8704;
__device__ __forceinline__ f32x2 cmul(f32x2 a, f32x2 b) { f32x2 ax = {a.x, a.x}, ay = {a.y, a.y}, bq = {-b.y, b.x}; return ax * b + ay * bq; }
__device__ __forceinline__ f32x2 cmulc(f32x2 a, f32x2 b) { f32x2 ax = {a.x, a.x}, ay = {a.y, a.y}, bc = {b.x, -b.y}, bq = {b.y, b.x}; return ax * bc + ay * bq; }
__device__ __forceinline__ f32x2 cmul_bf(f32x2 a, f32x2 b) { f32x2 t, r;
    asm("v_pk_mul_f32 %0, %1, %2 op_sel:[0,0] op_sel_hi:[0,1]" : "=v"(t) : "v"(a), "v"(b));
    asm("v_pk_fma_f32 %0, %1, %2, %3 op_sel:[1,1,0] op_sel_hi:[1,0,1] neg_lo:[0,1,0]" : "=v"(r) : "v"(a), "v"(b), "v"(t));
    return r; }
__device__ __forceinline__ f32x2 cmulc_bf(f32x2 a, f32x2 b) { f32x2 t, r;
    asm("v_pk_mul_f32 %0, %1, %2 op_sel:[0,0] op_sel_hi:[0,1] neg_hi:[0,1]" : "=v"(t) : "v"(a), "v"(b));
    asm("v_pk_fma_f32 %0, %1, %2, %3 op_sel:[1,1,0] op_sel_hi:[1,0,1]" : "=v"(r) : "v"(a), "v"(b), "v"(t));
    return r; }
struct Tw { f32x2 t1[8], t2[4], t3[2], t4; };
template <bool ZERO> __device__ __forceinline__ void mk_tw(Tw& T, float theta  ) {
    const float C16C[8] = {1.000000000f, 0.923879533f, 0.707106781f, 0.382683432f, 0.000000000f, -0.382683432f, -0.707106781f, -0.923879533f};
    const float C16S[8] = {0.000000000f, -0.382683432f, -0.707106781f, -0.923879533f, -1.000000000f, -0.923879533f, -0.707106781f, -0.382683432f};
    f32x2 W1; if (ZERO) { W1.x = 1.f; W1.y = 0.f; } else { W1.x = __builtin_amdgcn_cosf(theta); W1.y = -__builtin_amdgcn_sinf(theta); }
    const f32x2 W2 = cmul(W1, W1), W4 = cmul(W2, W2), W8 = cmul(W4, W4);
#pragma unroll
    for (int m = 0; m < 8; ++m) { f32x2 c; c.x = C16C[m]; c.y = C16S[m]; T.t1[m] = cmul(W1, c); }
#pragma unroll
    for (int m = 0; m < 4; ++m) { f32x2 c; c.x = C16C[2 * m]; c.y = C16S[2 * m]; T.t2[m] = cmul(W2, c); }
    T.t3[0] = W4; T.t3[1].x = W4.y; T.t3[1].y = -W4.x;
    T.t4 = W8;
}
__device__ __forceinline__ void r16_dif(f32x2 (&v)[16], const Tw& T) {
#pragma unroll
    for (int m = 0; m < 8; ++m) { const f32x2 a = v[m], b = v[m + 8]; v[m] = a + b; v[m + 8] = cmul_bf(a - b, T.t1[m]); }
#pragma unroll
    for (int blk = 0; blk < 16; blk += 8)
#pragma unroll
        for (int m = 0; m < 4; ++m) { const f32x2 a = v[blk + m], b = v[blk + m + 4]; v[blk + m] = a + b; v[blk + m + 4] = cmul_bf(a - b, T.t2[m]); }
#pragma unroll
    for (int blk = 0; blk < 16; blk += 4)
#pragma unroll
        for (int m = 0; m < 2; ++m) { const f32x2 a = v[blk + m], b = v[blk + m + 2]; v[blk + m] = a + b; v[blk + m + 2] = cmul_bf(a - b, T.t3[m]); }
#pragma unroll
    for (int q = 0; q < 16; q += 2) { const f32x2 a = v[q], b = v[q + 1]; v[q] = a + b; v[q + 1] = cmul_bf(a - b, T.t4); }
}
__device__ __forceinline__ void r16_dit(f32x2 (&v)[16], const Tw& T) {
#pragma unroll
    for (int q = 0; q < 16; q += 2) { const f32x2 a = v[q], b = cmulc_bf(v[q + 1], T.t4); v[q] = a + b; v[q + 1] = a - b; }
#pragma unroll
    for (int blk = 0; blk < 16; blk += 4)
#pragma unroll
        for (int m = 0; m < 2; ++m) { const f32x2 a = v[blk + m], b = cmulc_bf(v[blk + m + 2], T.t3[m]); v[blk + m] = a + b; v[blk + m + 2] = a - b; }
#pragma unroll
    for (int blk = 0; blk < 16; blk += 8)
#pragma unroll
        for (int m = 0; m < 4; ++m) { const f32x2 a = v[blk + m], b = cmulc_bf(v[blk + m + 4], T.t2[m]); v[blk + m] = a + b; v[blk + m + 4] = a - b; }
#pragma unroll
    for (int m = 0; m < 8; ++m) { const f32x2 a = v[m], b = cmulc_bf(v[m + 8], T.t1[m]); v[m] = a + b; v[m + 8] = a - b; }
}
__device__ __forceinline__ f32x2 mul_mi(f32x2 d) { f32x2 r; r.x = d.y; r.y = -d.x; return r; }
__device__ __forceinline__ f32x2 mul_pi(f32x2 d) { f32x2 r; r.x = -d.y; r.y = d.x; return r; }
__device__ __forceinline__ f32x2 c16(int m) {
    const float C16C[8] = {1.000000000f, 0.923879533f, 0.707106781f, 0.382683432f, 0.000000000f, -0.382683432f, -0.707106781f, -0.923879533f};
    const float C16S[8] = {0.000000000f, -0.382683432f, -0.707106781f, -0.923879533f, -1.000000000f, -0.923879533f, -0.707106781f, -0.382683432f};
    f32x2 c; c.x = C16C[m]; c.y = C16S[m]; return c;
}
__device__ __forceinline__ void r16_dif0(f32x2 (&v)[16]) {
#pragma unroll
    for (int m = 0; m < 8; ++m) { const f32x2 a = v[m], b = v[m + 8], d = a - b; v[m] = a + b; v[m + 8] = (m == 0) ? d : (m == 4) ? mul_mi(d) : cmul_bf(d, c16(m)); }
#pragma unroll
    for (int blk = 0; blk < 16; blk += 8)
#pragma unroll
        for (int m = 0; m < 4; ++m) { const f32x2 a = v[blk + m], b = v[blk + m + 4], d = a - b; v[blk + m] = a + b; v[blk + m + 4] = (m == 0) ? d : (m == 2) ? mul_mi(d) : cmul_bf(d, c16(2 * m)); }
#pragma unroll
    for (int blk = 0; blk < 16; blk += 4)
#pragma unroll
        for (int m = 0; m < 2; ++m) { const f32x2 a = v[blk + m], b = v[blk + m + 2], d = a - b; v[blk + m] = a + b; v[blk + m + 2] = (m == 0) ? d : mul_mi(d); }
#pragma unroll
    for (int q = 0; q < 16; q += 2) { const f32x2 a = v[q], b = v[q + 1]; v[q] = a + b; v[q + 1] = a - b; }
}
__device__ __forceinline__ void r16_dit0(f32x2 (&v)[16]) {
#pragma unroll
    for (int q = 0; q < 16; q += 2) { const f32x2 a = v[q], b = v[q + 1]; v[q] = a + b; v[q + 1] = a - b; }
#pragma unroll
    for (int blk = 0; blk < 16; blk += 4)
#pragma unroll
        for (int m = 0; m < 2; ++m) { const f32x2 a = v[blk + m], b = (m == 0) ? v[blk + m + 2] : mul_pi(v[blk + m + 2]); v[blk + m] = a + b; v[blk + m + 2] = a - b; }
#pragma unroll
    for (int blk = 0; blk < 16; blk += 8)
#pragma unroll
        for (int m = 0; m < 4; ++m) { const f32x2 a = v[blk + m], x = v[blk + m + 4], b = (m == 0) ? x : (m == 2) ? mul_pi(x) : cmulc_bf(x, c16(2 * m)); v[blk + m] = a + b; v[blk + m + 4] = a - b; }
#pragma unroll
    for (int m = 0; m < 8; ++m) { const f32x2 a = v[m], x = v[m + 8], b = (m == 0) ? x : (m == 4) ? mul_pi(x) : cmulc_bf(x, c16(m)); v[m] = a + b; v[m + 8] = a - b; }
}
__device__ __forceinline__ f32x2 ec32(f32x2 E, int k) {
    const float C32C[16] = {1.000000000f, 0.980785280f, 0.923879533f, 0.831469612f, 0.707106781f, 0.555570233f, 0.382683432f, 0.195090322f, 0.000000000f, -0.195090322f, -0.382683432f, -0.555570233f, -0.707106781f, -0.831469612f, -0.923879533f, -0.980785280f};
    const float C32S[16] = {0.000000000f, -0.195090322f, -0.382683432f, -0.555570233f, -0.707106781f, -0.831469612f, -0.923879533f, -0.980785280f, -1.000000000f, -0.980785280f, -0.923879533f, -0.831469612f, -0.707106781f, -0.555570233f, -0.382683432f, -0.195090322f};
    f32x2 c; c.x = C32C[k]; c.y = C32S[k]; return cmul(E, c);
}
__device__ __forceinline__ f32x2 tw8(f32x2 E0, int e) {
    const float D8C[8] = {1.0000000000f, 0.9999997059f, 0.9999988235f, 0.9999973528f, 0.9999952938f, 0.9999926466f, 0.9999894111f, 0.9999855873f};
    const float D8S[8] = {0.0000000000f, -0.0007669903f, -0.0015339802f, -0.0023009692f, -0.0030679568f, -0.0038349426f, -0.0046019261f, -0.0053689070f};
    f32x2 d; d.x = D8C[e]; d.y = D8S[e]; return cmul(E0, d);
}
__device__ __forceinline__ void sconv8(const float (&raw)[10], float w0, float w1, float w2, float bb, float (&o)[8]) {
#pragma unroll
    for (int e = 0; e < 8; ++e) o[e] = w0 * raw[e] + w1 * raw[e + 1] + w2 * raw[e + 2] + bb;
}
__device__ __forceinline__ void unpack8(u32x4 w, unsigned short l, unsigned short r, bool hasl, bool hasr, float (&raw)[10]) {
    raw[0] = hasl ? bf2f(l) : 0.f; raw[9] = hasr ? bf2f(r) : 0.f;
    raw[1] = __uint_as_float(w.x << 16); raw[2] = __uint_as_float(w.x & 0xffff0000u); raw[3] = __uint_as_float(w.y << 16); raw[4] = __uint_as_float(w.y & 0xffff0000u);
    raw[5] = __uint_as_float(w.z << 16); raw[6] = __uint_as_float(w.z & 0xffff0000u); raw[7] = __uint_as_float(w.w << 16); raw[8] = __uint_as_float(w.w & 0xffff0000u);
}

#define MFMA16(a, b, c) __builtin_amdgcn_mfma_f32_16x16x32_bf16((a), (b), (c), 0, 0, 0)
constexpr int ATT_KC_STRIDE = 72, ATT_VC_STRIDE = 264;
constexpr int ATT_KC_OFF = 0, ATT_VC_OFF = 256 * 72 * 2, ATT_RPB_OFF = ATT_VC_OFF + 64 * 264 * 2;
__device__ __forceinline__ bf16x8 cat8(s16x4 lo, s16x4 hi) { bf16x8 r; r[0] = lo[0]; r[1] = lo[1]; r[2] = lo[2]; r[3] = lo[3]; r[4] = hi[0]; r[5] = hi[1]; r[6] = hi[2]; r[7] = hi[3]; return r; }
template <int NTL> __device__ __forceinline__ void sm_step(f32x4 (&S)[4], float& m_run, float& l_run, float& alpha, bf16x8& pf0, bf16x8& pf1) {
    float mloc = -1e30f;
#pragma unroll
    for (int ct = 0; ct < NTL; ++ct)
#pragma unroll
        for (int j = 0; j < 4; ++j) mloc = fmaxf(mloc, S[ct][j]);
    mloc = fmaxf(mloc, __shfl_xor(mloc, 16)); mloc = fmaxf(mloc, __shfl_xor(mloc, 32));
    const float m_new = fmaxf(m_run, mloc); alpha = __builtin_amdgcn_exp2f(m_run - m_new); m_run = m_new;
    float psum = 0.f;
#pragma unroll
    for (int ct = 0; ct < NTL; ++ct)
#pragma unroll
        for (int j = 0; j < 4; ++j) { const float p = __builtin_amdgcn_exp2f(S[ct][j] - m_new); psum += p; S[ct][j] = p; }
    l_run = l_run * alpha + psum;
#pragma unroll
    for (int j = 0; j < 4; ++j) { pf0[j] = (short)f2bf(S[0][j]); pf0[4 + j] = (short)f2bf(S[1][j]); pf1[j] = (short)f2bf(S[2][j]); pf1[4 + j] = (NTL == 4) ? (short)f2bf(S[3][j]) : (short)0; }
}
template <bool ROT> __device__ __forceinline__ void q_frags(const bf16* qp, const f32x2* rope, int r, int c, int g, bf16x8& q0, bf16x8& q1) {
    const float QS = 0.125f * 1.4426950408889634f;
    const bf16x8 qa = *(const bf16x8*)qp, qb = *(const bf16x8*)(qp + 32);
#pragma unroll
    for (int e = 0; e < 4; ++e) {
        const float x1 = bf2f((unsigned short)qa[e]) * QS, x2 = bf2f((unsigned short)qa[4 + e]) * QS, y1 = bf2f((unsigned short)qb[e]) * QS, y2 = bf2f((unsigned short)qb[4 + e]) * QS;
        if (ROT) { const f32x2 ca = rope[r * 16 + 4 * g + e], cb = rope[c * 16 + 4 * g + e];
            q0[e] = (short)f2bf(x1 * ca.x - x2 * ca.y); q0[4 + e] = (short)f2bf(x2 * ca.x + x1 * ca.y); q1[e] = (short)f2bf(y1 * cb.x - y2 * cb.y); q1[4 + e] = (short)f2bf(y2 * cb.x + y1 * cb.y); }
        else { q0[e] = (short)f2bf(x1); q0[4 + e] = (short)f2bf(x2); q1[e] = (short)f2bf(y1); q1[4 + e] = (short)f2bf(y2); } }
}
__device__ __forceinline__ unsigned bias_idx(int t, int ct0, int g, int c, int sc0) {
    unsigned r = 0u;
#pragma unroll
    for (int j = 0; j < 4; ++j) { const int kc = 16 * (ct0 + t) + 4 * g + j; const bool valid = (kc >= sc0) && (kc < sc0 + 16);
        const int dc = min(max(kc - c, -15), 15) + 15; r |= (unsigned)(valid ? dc : 31) << (8 * j); }
    return r;
}
__device__ __forceinline__ void bias_mask(f32x4 (&S)[4], const LAS float* bp, const unsigned (&idx)[3]) {
#pragma unroll
    for (int t = 0; t < 3; ++t)
#pragma unroll
        for (int j = 0; j < 4; ++j) S[t][j] += bp[(idx[t] >> (8 * j)) & 0xffu];
}
__device__ __forceinline__ void attn_task32(const bf16* QKG, const bf16* VHT, LAS unsigned char* lds, const f32x2* rope, bf16* YNA, int b, int h, int r, int half, int lane) {
    const int lq = lane & 15, g = lane >> 4, cA = 32 * half + lq, cB = cA + 16, ct0 = half;
    const size_t rowA = (size_t)b * 4096 + r * 64 + cA;
    const LAS bf16* KC_L = (const LAS bf16*)(lds + ATT_KC_OFF); const LAS bf16* VC_L = (const LAS bf16*)(lds + ATT_VC_OFF); const LAS float* RPB_L = (const LAS float*)(lds + ATT_RPB_OFF);
    bf16x8 qA0r, qA1r, qB0r, qB1r;
    q_frags<true>(QKG + rowA * 3072 + h * 64 + 8 * g, rope, r, cA, g, qA0r, qA1r);
    q_frags<true>(QKG + (rowA + 16) * 3072 + h * 64 + 8 * g, rope, r, cB, g, qB0r, qB1r);
    const int scA = min(max(cA - 8, 0), 48), scB = min(max(cB - 8, 0), 48), rs = min(max(r - 4, 0), 56);
    unsigned ixA[3], ixB[3];
#pragma unroll
    for (int t = 0; t < 3; ++t) { ixA[t] = bias_idx(t, ct0, g, cA, scA); ixB[t] = bias_idx(t, ct0, g, cB, scB); }
    float mA = -1e30f, lA = 0.f, mB = -1e30f, lB = 0.f;
    f32x4 OA[4], OB[4];
#pragma unroll
    for (int dt = 0; dt < 4; ++dt) { OA[dt] = (f32x4){0.f, 0.f, 0.f, 0.f}; OB[dt] = (f32x4){0.f, 0.f, 0.f, 0.f}; }
    const f32x4 zero4 = {0.f, 0.f, 0.f, 0.f};
    const bf16* kb = QKG + ((size_t)b * 4096 + rs * 64 + 16 * ct0 + lq) * 3072 + 512 + h * 64 + 8 * g;
    const bf16* vb = VHT + (size_t)(h * 64 + lq) * 32768 + (size_t)b * 4096 + rs * 64 + 16 * ct0 + 4 * g;
    bf16x8 kc[3][2];
#pragma unroll
    for (int t = 0; t < 3; ++t) { kc[t][0] = *(const bf16x8*)(kb + (size_t)t * 16 * 3072); kc[t][1] = *(const bf16x8*)(kb + (size_t)t * 16 * 3072 + 32); }
#pragma unroll 1
    for (int i = 0; i < 8; ++i) {
        s16x4 vv[4][3];
#pragma unroll
        for (int dt = 0; dt < 4; ++dt)
#pragma unroll
            for (int t = 0; t < 3; ++t) vv[dt][t] = *(const s16x4*)(vb + (size_t)dt * 16 * 32768 + 16 * t);
        f32x4 SA[4], SB[4];
#pragma unroll
        for (int t = 0; t < 3; ++t) { SA[t] = MFMA16(kc[t][0], qA0r, zero4); SA[t] = MFMA16(kc[t][1], qA1r, SA[t]); SB[t] = MFMA16(kc[t][0], qB0r, zero4); SB[t] = MFMA16(kc[t][1], qB1r, SB[t]); }
        __builtin_amdgcn_sched_barrier(0);
        { const bf16* kb2 = kb + ((i < 7) ? (size_t)64 * 3072 : 0);
#pragma unroll
          for (int t = 0; t < 3; ++t) { kc[t][0] = *(const bf16x8*)(kb2 + (size_t)t * 16 * 3072); kc[t][1] = *(const bf16x8*)(kb2 + (size_t)t * 16 * 3072 + 32); } }
        __builtin_amdgcn_sched_barrier(0);
        const LAS float* bp = RPB_L + (rs + i - r + 7) * 32;
        bias_mask(SA, bp, ixA); bias_mask(SB, bp, ixB);
        float aA, aB; bf16x8 pA0, pA1, pB0, pB1;
        sm_step<3>(SA, mA, lA, aA, pA0, pA1); sm_step<3>(SB, mB, lB, aB, pB0, pB1);
        const s16x4 z4 = {0, 0, 0, 0};
#pragma unroll
        for (int dt = 0; dt < 4; ++dt) { const bf16x8 va = cat8(vv[dt][0], vv[dt][1]), vb2 = cat8(vv[dt][2], z4);
            OA[dt] = OA[dt] * aA; OA[dt] = MFMA16(va, pA0, OA[dt]); OA[dt] = MFMA16(vb2, pA1, OA[dt]);
            OB[dt] = OB[dt] * aB; OB[dt] = MFMA16(va, pB0, OB[dt]); OB[dt] = MFMA16(vb2, pB1, OB[dt]); }
        kb += (size_t)64 * 3072; vb += 64;
    }
    bf16x8 qA0, qA1, qB0, qB1;
    q_frags<false>(QKG + rowA * 3072 + h * 64 + 8 * g, rope, r, cA, g, qA0, qA1);
    q_frags<false>(QKG + (rowA + 16) * 3072 + h * 64 + 8 * g, rope, r, cB, g, qB0, qB1);
#pragma unroll 1
    for (int cc = 0; cc < 4; ++cc) {
        f32x4 SA[4], SB[4];
#pragma unroll
        for (int ct = 0; ct < 4; ++ct) { const LAS bf16* kp = KC_L + (64 * cc + 16 * ct + lq) * ATT_KC_STRIDE + 8 * g;
            const bf16x8 k0 = *(const LAS bf16x8*)kp, k1 = *(const LAS bf16x8*)(kp + 32);
            SA[ct] = MFMA16(k0, qA0, zero4); SA[ct] = MFMA16(k1, qA1, SA[ct]); SB[ct] = MFMA16(k0, qB0, zero4); SB[ct] = MFMA16(k1, qB1, SB[ct]); }
        float aA, aB; bf16x8 pA0, pA1, pB0, pB1;
        sm_step<4>(SA, mA, lA, aA, pA0, pA1); sm_step<4>(SB, mB, lB, aB, pB0, pB1);
#pragma unroll
        for (int dt = 0; dt < 4; ++dt) { const LAS bf16* vp = VC_L + (16 * dt + lq) * ATT_VC_STRIDE + 64 * cc + 4 * g;
            const bf16x8 va = cat8(*(const LAS s16x4*)vp, *(const LAS s16x4*)(vp + 16)), vb2 = cat8(*(const LAS s16x4*)(vp + 32), *(const LAS s16x4*)(vp + 48));
            OA[dt] = OA[dt] * aA; OA[dt] = MFMA16(va, pA0, OA[dt]); OA[dt] = MFMA16(vb2, pA1, OA[dt]);
            OB[dt] = OB[dt] * aB; OB[dt] = MFMA16(va, pB0, OB[dt]); OB[dt] = MFMA16(vb2, pB1, OB[dt]); }
    }
    { float l = lA; l += __shfl_xor(l, 16); l += __shfl_xor(l, 32); const float inv = 1.0f / l; bf16* op = YNA + rowA * 512 + h * 64 + 4 * g;
#pragma unroll
      for (int dt = 0; dt < 4; ++dt) { const f32x4 o = OA[dt] * inv; u32x2 w; w.x = pk2(o[0], o[1]); w.y = pk2(o[2], o[3]); *(u32x2*)(op + 16 * dt) = w; } }
    { float l = lB; l += __shfl_xor(l, 16); l += __shfl_xor(l, 32); const float inv = 1.0f / l; bf16* op = YNA + (rowA + 16) * 512 + h * 64 + 4 * g;
#pragma unroll
      for (int dt = 0; dt < 4; ++dt) { const f32x4 o = OB[dt] * inv; u32x2 w; w.x = pk2(o[0], o[1]); w.y = pk2(o[2], o[3]); *(u32x2*)(op + 16 * dt) = w; } }
}

struct Args { const float* in[26]; float* out; unsigned char* ws; int ph_lo, ph_hi; };
enum { I_X = 0, I_C, I_CTX, I_CCTX, I_WADA, I_BADA, I_N1G, I_N2G, I_WIN, I_RPB, I_HCW, I_HCB, I_HW1, I_HB1, I_HW2, I_HB2, I_HFR, I_HW3, I_HBIAS, I_WNAO, I_WHYO, I_WOUT, I_FW1, I_FW3, I_FW2, I_FING };
constexpr int NPHASE = 10;

__global__ void __launch_bounds__(NT, 2) mega_fwd(Args args) {
    extern __shared__ __attribute__((aligned(16))) unsigned char lds_raw[];
    LAS unsigned char* lds = (LAS unsigned char*)lds_raw;
    cg::grid_group grid = cg::this_grid();
    const int tid = threadIdx.x, lane = tid & 63, wave = __builtin_amdgcn_readfirstlane(tid >> 6);
    const int G = gridDim.x, bx = blockIdx.x;
    const int vcu = (G % 8 == 0) ? (bx % 8) * (G / 8) + bx / 8 : bx;
    const int gw = vcu * NW + wave, NGW = G * NW;
    unsigned char* ws = args.ws;
    const float* x = args.in[I_X]; float* out = args.out;
    bf16* WT_in = (bf16*)(ws + WS_WIN); bf16* WT_nao = (bf16*)(ws + WS_WNAO); bf16* WT_hyo = (bf16*)(ws + WS_WHYO); bf16* WT_out = (bf16*)(ws + WS_WOUT);
    bf16* WT_13 = (bf16*)(ws + WS_W13); bf16* WT_2 = (bf16*)(ws + WS_W2);
    float* mod = (float*)(ws + WS_MOD); f32x2* rope = (f32x2*)(ws + WS_ROPE); float* hid2 = (float*)(ws + WS_HID2);
    float* K2 = (float*)(ws + WS_K2); bf16* YHY = (bf16*)(ws + WS_K2);
    bf16* H = (bf16*)(ws + WS_H); bf16* YNA = (bf16*)(ws + WS_H);
    bf16* QKG = (bf16*)(ws + WS_QKG); bf16* HID = (bf16*)(ws + WS_QKG);
    bf16* VHT = (bf16*)out; float* M1 = out;
    bf16* YHT = (bf16*)(ws + WS_YHT); bf16* MB = (bf16*)(ws + WS_MB);
    bf16* KC = (bf16*)(ws + WS_KC); bf16* VCT = (bf16*)(ws + WS_VCT); float* Z1T = (float*)(ws + WS_Z1T);
    const int lo = args.ph_lo, hi = args.ph_hi;
    unsigned long long* rowss2 = (unsigned long long*)(ws + WS_RSS2); unsigned long long* rowss3 = (unsigned long long*)(ws + WS_RSS3); float* sW = (float*)(ws + WS_SW);
    { volatile LAS unsigned* MISC = (volatile LAS unsigned*)(lds + MISC_OFF);
      if (tid < 64) MISC[tid] = 0u; }
    __syncthreads();
    XcdBarrier bar = xcd_barrier_post((unsigned*)(ws + WS_CTL), (volatile LAS unsigned*)(lds + MISC_OFF) + 8);
    if (lo < 0) grid.sync();
#define IN(k) (lo <= (k) && (k) < hi)
#define SEAM(k) do { if (IN(k) && IN((k) + 1)) xcd_barrier(bar); } while (0)

    if (IN(0)) {
        for (int task = vcu; task < NMOD / 64; task += G) {
            LAS float* sc = (LAS float*)lds; LAS float* red = (LAS float*)(lds + 40960);
            for (int i = tid; i < 9 * 1024; i += NT) { const int b = i >> 10, k = i & 1023; const float v = (b < 8) ? args.in[I_C][b * 1024 + k] : args.in[I_CCTX][k]; sc[i] = v / (1.0f + __expf(-v)); }
            __syncthreads();
            const int j = 64 * task + lane, k0 = 128 * wave; float acc[9];
#pragma unroll
            for (int b = 0; b < 9; ++b) acc[b] = 0.f;
            const float* wp = args.in[I_WADA] + (size_t)k0 * NMOD + j;
#pragma unroll 32
            for (int kk = 0; kk < 128; ++kk) { const float w = __builtin_nontemporal_load(wp + (size_t)kk * NMOD);
#pragma unroll
                for (int b = 0; b < 9; ++b) acc[b] += sc[b * 1024 + k0 + kk] * w; }
#pragma unroll
            for (int b = 0; b < 9; ++b) red[(wave * 9 + b) * 64 + lane] = acc[b];
            __syncthreads();
            for (int i = tid; i < 9 * 64; i += NT) { const int b = i >> 6, l = i & 63; float s = 0.f;
#pragma unroll
                for (int w = 0; w < 8; ++w) s += red[(w * 9 + b) * 64 + l];
                mod[b * NMOD + 64 * task + l] = s + args.in[I_BADA][64 * task + l]; }
            __syncthreads();
        }
        for (int i = vcu * NT + tid; i < 2 * MTOK; i += G * NT) { if (i < MTOK) rowss2[i] = 0ull; else rowss3[i - MTOK] = 0ull; }
        for (int i = bx * NT + tid; i < 1024; i += G * NT) { const int pos = i >> 4, fi = i & 15; const float inv = powf(10000.0f, -(float)fi / 16.0f), ang = (float)pos * inv; f32x2 cs; cs.x = cosf(ang); cs.y = sinf(ang); rope[i] = cs; }
        { const int ngv_ = NMOD / 64; const bool spare_ = G >= 2 * ngv_; const int hw0 = spare_ ? (vcu - ngv_) * NW + wave : gw, hnw = spare_ ? (G - ngv_) * NW : NGW;
          LAS float* hs = (LAS float*)(lds + wave * 16384);
          if (!spare_ || vcu >= ngv_)
          for (int p = hw0; p < 4096; p += hnw) {
            const float wv = 6.283185307179586f * (float)p / 4096.0f; float zv = 0.f;
            if (lane == 0) zv = (float)p / 4095.0f;
            else if (lane <= 16) { const float band = 1e-4f + (float)(lane - 1) * ((15.0f - 1e-4f) / 15.0f); zv = cosf(band * wv); }
            else if (lane <= 32) { const float band = 1e-4f + (float)(lane - 17) * ((15.0f - 1e-4f) / 15.0f); zv = sinf(-band * wv); }
            const float fr = args.in[I_HFR][lane];
            hs[lane] = zv;
            LDS_WAIT(); asm volatile("" ::: "memory");
            float a = args.in[I_HB1][lane];
#pragma unroll
            for (int e4 = 0; e4 < 8; ++e4) { const f32x4 z4 = *(const LAS f32x4*)(hs + 4 * e4); const float* w = args.in[I_HW1] + (4 * e4) * 64 + lane;
                a += (z4.x * w[0] + z4.y * w[64]) + (z4.z * w[128] + z4.w * w[192]); }
            a += hs[32] * args.in[I_HW1][32 * 64 + lane];
            const float h1 = sinf(fr * a);
            hs[64 + lane] = h1;
            LDS_WAIT(); asm volatile("" ::: "memory");
            float a2 = args.in[I_HB2][lane];
#pragma unroll
            for (int i4 = 0; i4 < 16; ++i4) { const f32x4 h4 = *(const LAS f32x4*)(hs + 64 + 4 * i4); const float* w = args.in[I_HW2] + (4 * i4) * 64 + lane;
                a2 += (h4.x * w[0] + h4.y * w[64]) + (h4.z * w[128] + h4.w * w[192]); }
            hid2[p * 64 + lane] = sinf(fr * a2);
            LDS_WAIT(); asm volatile("" ::: "memory");
          } }
        { LAS float* scr = (LAS float*)(lds + wave * 16384);
          constexpr int I0 = 16 * 160, I4 = 16 * 176, NIT = I0 + I4;
          const int ngv = NMOD / 64;
          const bool spare = G >= 2 * ngv; const int tw0 = spare ? (vcu - ngv) * NW + wave : gw, tnw = spare ? (G - ngv) * NW : NGW;
          if (!spare || vcu >= ngv)
          for (int it = tw0; it < NIT; it += tnw) {
              int r = it; const int l31 = lane & 31;
              if (r < I0) { const int kb = r / 160, nb = r % 160; tr_item(args.in[I_WIN], 5120, mapcol_in(32 * nb + l31), WT_in, 1024, 32 * nb, 64 * kb, scr, lane); continue; } r -= I0;
              { const int kb = r / 176, nb = r % 176, n0 = 32 * nb, tile = n0 >> 8, within = n0 & 255;
                  tr_item((within < 128) ? args.in[I_FW1] : args.in[I_FW3], FF, tile * 128 + (within & 127) + l31, WT_13, 1024, n0, 64 * kb, scr, lane); }
          } }
    }
    SEAM(0);

    if (IN(1)) {
        {
          const int m0 = gw * (MALL / (NGW)), nrow = MALL / NGW;
          if (MALL % NGW == 0) {
            int bcur = -1; f32x4 gsc[4], shv[4];
            for (int mm = 0; mm < nrow; mm += 4) {
                f32x4 v[4][4];
#pragma unroll
                for (int q = 0; q < 4; ++q) { const int m = m0 + mm + q; if (mm + q < nrow) { const float* src = (m < MTOK) ? x + (size_t)m * DM : args.in[I_CTX] + (size_t)(m - MTOK) * DM;
#pragma unroll
                    for (int j = 0; j < 4; ++j) v[q][j] = __builtin_nontemporal_load((const f32x4*)src + lane + 64 * j); } }
#pragma unroll
                for (int q = 0; q < 4; ++q) { const int m = m0 + mm + q; if (mm + q < nrow) {
                    const int b = (m < MTOK) ? (m >> 12) : 8;
                    if (b != bcur) { bcur = b; const float* mb = mod + (size_t)b * NMOD;
#pragma unroll
                        for (int j = 0; j < 4; ++j) { const int k = 4 * (lane + 64 * j); gsc[j] = *(const f32x4*)(args.in[I_N1G] + k) * (*(const f32x4*)(mb + 1024 + k) + 1.0f); shv[j] = *(const f32x4*)(mb + k); } }
                    float ssum = 0.f;
#pragma unroll
                    for (int j = 0; j < 4; ++j) ssum += (v[q][j].x * v[q][j].x + v[q][j].y * v[q][j].y) + (v[q][j].z * v[q][j].z + v[q][j].w * v[q][j].w);
                    const float rstd = __builtin_amdgcn_rsqf(wave_sum(ssum) * (1.f / 1024.f) + 1e-6f);
#pragma unroll
                    for (int j = 0; j < 4; ++j) { const f32x4 y = v[q][j] * rstd * gsc[j] + shv[j]; u32x2 w; w.x = pk2(y.x, y.y); w.y = pk2(y.z, y.w); *(u32x2*)(H + (size_t)m * DM + 4 * (lane + 64 * j)) = w; } } }
            }
          } else {
            for (int m = gw; m < MALL; m += NGW) {
                const bool lat = m < MTOK; const float* src = lat ? x + (size_t)m * DM : args.in[I_CTX] + (size_t)(m - MTOK) * DM; const float* mb = mod + (size_t)(lat ? (m >> 12) : 8) * NMOD;
                norm_row(src, H + (size_t)m * DM, args.in[I_N1G], mb, mb + 1024, lane); }
          } }
        for (int n = gw; n < 2 * FF; n += NGW) {
            const u32x4 wa = *(const u32x4*)(WT_13 + (size_t)n * 1024 + 8 * lane), wb = *(const u32x4*)(WT_13 + (size_t)n * 1024 + 512 + 8 * lane);
            float wf[16];
            wf[0] = __uint_as_float(wa.x << 16); wf[1] = __uint_as_float(wa.x & 0xffff0000u); wf[2] = __uint_as_float(wa.y << 16); wf[3] = __uint_as_float(wa.y & 0xffff0000u);
            wf[4] = __uint_as_float(wa.z << 16); wf[5] = __uint_as_float(wa.z & 0xffff0000u); wf[6] = __uint_as_float(wa.w << 16); wf[7] = __uint_as_float(wa.w & 0xffff0000u);
            wf[8] = __uint_as_float(wb.x << 16); wf[9] = __uint_as_float(wb.x & 0xffff0000u); wf[10] = __uint_as_float(wb.y << 16); wf[11] = __uint_as_float(wb.y & 0xffff0000u);
            wf[12] = __uint_as_float(wb.z << 16); wf[13] = __uint_as_float(wb.z & 0xffff0000u); wf[14] = __uint_as_float(wb.w << 16); wf[15] = __uint_as_float(wb.w & 0xffff0000u);
#pragma unroll
            for (int b = 0; b < 8; ++b) { const float* sp = mod + (size_t)b * NMOD + 3072 + 8 * lane;
                const f32x4 s0 = *(const f32x4*)sp, s1 = *(const f32x4*)(sp + 4), s2 = *(const f32x4*)(sp + 512), s3 = *(const f32x4*)(sp + 516);
                float d = (wf[0] * s0[0] + wf[1] * s0[1]) + (wf[2] * s0[2] + wf[3] * s0[3]) + (wf[4] * s1[0] + wf[5] * s1[1]) + (wf[6] * s1[2] + wf[7] * s1[3])
                        + (wf[8] * s2[0] + wf[9] * s2[1]) + (wf[10] * s2[2] + wf[11] * s2[3]) + (wf[12] * s3[0] + wf[13] * s3[1]) + (wf[14] * s3[2] + wf[15] * s3[3]);
                d = wave_sum(d); if (lane == 0) sW[b * 2 * FF + n] = d; }
        }
        for (int task = bx; task < 256; task += G) {
            const int pc = task >> 5, col0 = 64 * (task & 31);
            LAS float* w3s = (LAS float*)lds;
            for (int i = tid; i < 4096; i += NT) { const int j = i >> 6, cc = i & 63; w3s[cc * 64 + j] = args.in[I_HW3][j * 2048 + col0 + cc]; }
            __syncthreads();
            const int p = 512 * pc + tid; f32x4 hv[16];
#pragma unroll
            for (int q = 0; q < 16; ++q) hv[q] = *(const f32x4*)(hid2 + (size_t)p * 64 + 4 * q);
            const int d = col0 >> 10, n = (col0 >> 9) & 1; const float tn = (float)p / 4095.0f;
            const float min_decay = -3.0701134573253945f, max_decay = -15.350567286626973f;
#pragma unroll 1
            for (int cc = 0; cc < 64; ++cc) {
                float acc = 0.f;
#pragma unroll
                for (int q = 0; q < 16; ++q) { const f32x4 w = *(const LAS f32x4*)(w3s + cc * 64 + 4 * q); acc += (hv[q].x * w.x + hv[q].y * w.y) + (hv[q].z * w.z + hv[q].w * w.w); }
                const int c = (col0 + cc) & 511; const float delta = fabsf(min_decay + (float)c * ((max_decay - min_decay) / 511.0f));
                float val = acc * __expf(-tn * delta);
                float* kf = K2 + (size_t)(n * 512 + c) * 8192;
                if (d == 0) { if (p == 0) val += args.in[I_HBIAS][n * 512 + c]; kf[p] = val; }
                else { if (p == 0) kf[4096] = 0.f; else kf[8192 - p] = val; }
            }
            __syncthreads();
        }
    }
    SEAM(1);

    if (IN(2)) {
        { pg8::Gemm g{H, WT_in, MTOK, 3072, 1024}; pg8::StaticOrder S; S.init(MTOK, 3072, G, bx); ep::EpiQKG E{QKG, rope};
          pg8::gemm_phase<ep::EpiQKG, pg8::StaticOrder, true, true>(lds, g, S, E); }
        { pg8::Gemm g{WT_in + (size_t)3072 * 1024, H, 2048, MTOK, 1024}; pg8::StaticOrder S; S.init(2048, MTOK, G, bx); ep::EpiPlain E{VHT, MTOK};
          pg8::gemm_phase<ep::EpiPlain, pg8::StaticOrder, true, true>(lds, g, S, E); }
        { pg8::Gemm g{H + (size_t)MTOK * 1024, WT_in + (size_t)512 * 1024, MCTX, 512, 1024}; pg8::StaticOrder S; S.init(MCTX, 512, G, bx); ep::EpiPlain E{KC, 512};
          pg8::gemm_phase<ep::EpiPlain, pg8::StaticOrder, true, true>(lds, g, S, E); }
        { pg8::Gemm g{WT_in + (size_t)3072 * 1024, H + (size_t)MTOK * 1024, 512, MCTX, 1024}; pg8::StaticOrder S; S.init(512, MCTX, G, (bx + G - 16) % G); ep::EpiPlain E{VCT, MCTX};
          pg8::gemm_phase<ep::EpiPlain, pg8::StaticOrder, true, true>(lds, g, S, E); }
    }
    SEAM(2);

    if (IN(3)) {
        LAS f32x2* XP = (LAS f32x2*)lds; LAS f32x2* KHP = XP + XPAD;
        const float* cw = args.in[I_HCW]; const float* cb = args.in[I_HCB];
        const int hf = tid >> 8, uu = tid & 255, ulo = uu & 15, uhi = uu >> 4;
        const int pA0 = uu + (uu >> 4), pA = hf * 4352 + pA0, pB = hf * 4352 + uhi * 272 + ulo, pC = 17 * (hf * 256 + uu);
        const int t0 = 8 * tid, pF = t0 + (tid >> 1);
        const float thA = (float)uu * (1.0f / 4096.0f), thB = (float)ulo * (1.0f / 256.0f), thE = (float)uu * (1.0f / 8192.0f);
#define CONV_TW(T, TH, Z) Tw T; { float th_ = (TH); asm volatile("" : "+v"(th_)); mk_tw<Z>(T, th_); }
#define CONV_E(E) f32x2 E; { float th_ = thE; asm volatile("" : "+v"(th_)); E.x = __builtin_amdgcn_cosf(th_); E.y = -__builtin_amdgcn_sinf(th_); }
        const bool hasl = tid > 0, hasr = tid < 511;
        for (int c = vcu; c < 512; c += G) {
#pragma unroll 1
            for (int n = 0; n < 2; ++n) {
                f32x2 v[16];
                const bf16* hvrow = VHT + (size_t)(512 + c) * MTOK + t0;
                const float* zrow = Z1T + (size_t)c * 8 * 4096 + t0;
                u32x4 pa0, pa1, pc0, pc1; unsigned short ph0l = 0, ph0r = 0, ph1l = 0, ph1r = 0;
#define CONV_LOAD_U(B0) do { if (n == 0) { pa0 = __builtin_nontemporal_load((const u32x4*)(hvrow + (B0) * 4096)); pc0 = __builtin_nontemporal_load((const u32x4*)(hvrow + ((B0) + 1) * 4096)); \
        ph0l = hasl ? hvrow[(B0) * 4096 - 1] : (unsigned short)0; ph0r = hasr ? hvrow[(B0) * 4096 + 8] : (unsigned short)0; \
        ph1l = hasl ? hvrow[((B0) + 1) * 4096 - 1] : (unsigned short)0; ph1r = hasr ? hvrow[((B0) + 1) * 4096 + 8] : (unsigned short)0; pa1 = pa0; pc1 = pc0; } \
    else { pa0 = *(const u32x4*)(zrow + (B0) * 4096); pa1 = *(const u32x4*)(zrow + (B0) * 4096 + 4); pc0 = *(const u32x4*)(zrow + ((B0) + 1) * 4096); pc1 = *(const u32x4*)(zrow + ((B0) + 1) * 4096 + 4); } } while (0)
                CONV_LOAD_U(0);
                { const float* k2 = K2 + (size_t)(n * 512 + c) * 8192 + uu;
                  { CONV_E(E)
#pragma unroll
                  for (int k = 0; k < 16; ++k) { const float a = k2[256 * k], b = k2[4096 + 256 * k];
                      if (hf == 0) { v[k].x = a + b; v[k].y = 0.f; } else { const f32x2 w = ec32(E, k); v[k] = w * (a - b); } } }
                  { CONV_TW(TA, thA, false) r16_dif(v, TA); }
#pragma unroll
                  for (int k = 0; k < 16; ++k) KHP[pA + 272 * k] = v[k];
                  __syncthreads();
#pragma unroll
                  for (int k = 0; k < 16; ++k) v[k] = KHP[pB + 17 * k];
                  { CONV_TW(TB, thB, false) r16_dif(v, TB); }
#pragma unroll
                  for (int k = 0; k < 16; ++k) KHP[pB + 17 * k] = v[k];
                  __syncthreads();
#pragma unroll
                  for (int k = 0; k < 16; ++k) v[k] = KHP[pC + k];
                  r16_dif0(v);
#pragma unroll
                  for (int k = 0; k < 16; ++k) KHP[pC + k] = v[k] * (1.0f / 8192.0f);
                  __syncthreads(); }
                const int gcol = (n == 0 ? 512 : 1024) + c;
                const float gw0 = cw[gcol], gw1 = cw[1536 + gcol], gw2 = cw[3072 + gcol], gb = cb[gcol];
                const float vw0 = cw[c], vw1 = cw[1536 + c], vw2 = cw[3072 + c], vb = cb[c];
                const bf16* grow = VHT + (size_t)(512 + gcol) * MTOK + t0;
#pragma unroll 1
                for (int bp = 0; bp < 4; ++bp) {
                    const int b0 = 2 * bp, b1 = b0 + 1;
                    float u0[8], u1[8];
                    if (n == 0) { float raw[10]; unpack8(pa0, ph0l, ph0r, hasl, hasr, raw); sconv8(raw, vw0, vw1, vw2, vb, u0); unpack8(pc0, ph1l, ph1r, hasl, hasr, raw); sconv8(raw, vw0, vw1, vw2, vb, u1); }
                    else {
#pragma unroll
                        for (int e = 0; e < 4; ++e) { u0[e] = __uint_as_float(pa0[e]); u0[4 + e] = __uint_as_float(pa1[e]); u1[e] = __uint_as_float(pc0[e]); u1[4 + e] = __uint_as_float(pc1[e]); } }
                    f32x2 E0; { float th_ = (float)tid * (1.0f / 1024.0f); asm volatile("" : "+v"(th_)); E0.x = __builtin_amdgcn_cosf(th_); E0.y = -__builtin_amdgcn_sinf(th_); }
#pragma unroll
                    for (int e = 0; e < 8; ++e) { f32x2 w; w.x = u0[e]; w.y = u1[e]; XP[pF + e] = w; XP[4352 + pF + e] = cmul(w, tw8(E0, e)); }
                    if (bp < 3) CONV_LOAD_U(b0 + 2);
                    __syncthreads();
#pragma unroll
                    for (int k = 0; k < 16; ++k) v[k] = XP[pA + 272 * k];
                    { CONV_TW(TA, thA, false) r16_dif(v, TA); }
#pragma unroll
                    for (int k = 0; k < 16; ++k) XP[pA + 272 * k] = v[k];
                    __syncthreads();
#pragma unroll
                    for (int k = 0; k < 16; ++k) v[k] = XP[pB + 17 * k];
                    { CONV_TW(TB, thB, false) r16_dif(v, TB); }
#pragma unroll
                    for (int k = 0; k < 16; ++k) XP[pB + 17 * k] = v[k];
                    __syncthreads();
#pragma unroll
                    for (int k = 0; k < 16; ++k) v[k] = XP[pC + k];
                    r16_dif0(v);
#pragma unroll
                    for (int k = 0; k < 16; ++k) v[k] = cmul_bf(v[k], KHP[pC + k]);
                    r16_dit0(v);
#pragma unroll
                    for (int k = 0; k < 16; ++k) XP[pC + k] = v[k];
                    const u32x4 g0w = __builtin_nontemporal_load((const u32x4*)(grow + b0 * 4096)), g1w = __builtin_nontemporal_load((const u32x4*)(grow + b1 * 4096));
                    const unsigned short g0l = hasl ? grow[b0 * 4096 - 1] : (unsigned short)0, g0r = hasr ? grow[b0 * 4096 + 8] : (unsigned short)0;
                    const unsigned short g1l = hasl ? grow[b1 * 4096 - 1] : (unsigned short)0, g1r = hasr ? grow[b1 * 4096 + 8] : (unsigned short)0;
                    __syncthreads();
#pragma unroll
                    for (int k = 0; k < 16; ++k) v[k] = XP[pB + 17 * k];
                    { CONV_TW(TB, thB, false) r16_dit(v, TB); }
#pragma unroll
                    for (int k = 0; k < 16; ++k) XP[pB + 17 * k] = v[k];
                    __syncthreads();
#pragma unroll
                    for (int k = 0; k < 16; ++k) v[k] = XP[pA + 272 * k];
                    { CONV_TW(TA, thA, false) r16_dit(v, TA); }
#pragma unroll
                    for (int k = 0; k < 16; ++k) XP[pA + 272 * k] = v[k];
                    __syncthreads();
                    float raw[10], ga[8], gc[8];
                    unpack8(g0w, g0l, g0r, hasl, hasr, raw); sconv8(raw, gw0, gw1, gw2, gb, ga); unpack8(g1w, g1l, g1r, hasl, hasr, raw); sconv8(raw, gw0, gw1, gw2, gb, gc);
                    float y0[8], y1[8];
#pragma unroll
                    for (int e = 0; e < 8; ++e) { const f32x2 y = XP[pF + e] + cmulc(XP[4352 + pF + e], tw8(E0, e)); y0[e] = y.x * ga[e]; y1[e] = y.y * gc[e]; }
                    if (n == 0) { float* z0 = Z1T + ((size_t)c * 8 + b0) * 4096 + t0; float* z1 = Z1T + ((size_t)c * 8 + b1) * 4096 + t0;
                        *(f32x4*)z0 = (f32x4){y0[0], y0[1], y0[2], y0[3]}; *(f32x4*)(z0 + 4) = (f32x4){y0[4], y0[5], y0[6], y0[7]};
                        *(f32x4*)z1 = (f32x4){y1[0], y1[1], y1[2], y1[3]}; *(f32x4*)(z1 + 4) = (f32x4){y1[4], y1[5], y1[6], y1[7]}; }
                    else { u32x4 w0, w1; w0.x = pk2(y0[0], y0[1]); w0.y = pk2(y0[2], y0[3]); w0.z = pk2(y0[4], y0[5]); w0.w = pk2(y0[6], y0[7]);
                        w1.x = pk2(y1[0], y1[1]); w1.y = pk2(y1[2], y1[3]); w1.z = pk2(y1[4], y1[5]); w1.w = pk2(y1[6], y1[7]);
                        *(u32x4*)(YHT + (size_t)c * MTOK + b0 * 4096 + t0) = w0; *(u32x4*)(YHT + (size_t)c * MTOK + b1 * 4096 + t0) = w1; }
                }
            }
        }
        __syncthreads();
        for (int u = vcu; u < 256; u += G) {
            const int bh = u >> 2, b = bh >> 3, h = bh & 7, r0 = 16 * (u & 3);
            { LAS bf16* KC_L = (LAS bf16*)(lds + ATT_KC_OFF); LAS bf16* VC_L = (LAS bf16*)(lds + ATT_VC_OFF); LAS float* RPB_L = (LAS float*)(lds + ATT_RPB_OFF);
              for (int i = tid; i < 256 * 8; i += NT) { const int key = i >> 3, seg = i & 7; *(LAS u32x4*)(KC_L + key * ATT_KC_STRIDE + seg * 8) = *(const u32x4*)(KC + ((size_t)b * 256 + key) * 512 + h * 64 + seg * 8); }
              for (int i = tid; i < 64 * 32; i += NT) { const int dh = i >> 5, seg = i & 31; *(LAS u32x4*)(VC_L + dh * ATT_VC_STRIDE + seg * 8) = *(const u32x4*)(VCT + (size_t)(h * 64 + dh) * 2048 + (size_t)b * 256 + seg * 8); }
              for (int i = tid; i < 15 * 32; i += NT) { const int rr = i >> 5, cc = i & 31; RPB_L[i] = (cc < 31) ? args.in[I_RPB][h * 465 + rr * 31 + cc] * 1.4426950408889634f : -1e30f; } }
            __syncthreads();
#pragma unroll 1
            for (int it = 0; it < 4; ++it) attn_task32(QKG, VHT, lds, rope, YNA, b, h, r0 + 4 * it + (wave >> 1), wave & 1, lane);
            __syncthreads();
        }
    }
    SEAM(3);

    if (IN(4)) {
        { LAS float* scr = (LAS float*)(lds + wave * 16384);
          constexpr int I1 = 8 * 32, I2 = 8 * 32, I3 = 16 * 32, I5 = 44 * 32, NIT = I1 + I2 + I3 + I5;
          for (int it = gw; it < NIT; it += NGW) {
              int r = it; const int l31 = lane & 31;
              if (r < I1) { const int kb = r / 32, nb = r % 32; tr_item(args.in[I_WNAO], 1024, 32 * nb + l31, WT_nao, 512, 32 * nb, 64 * kb, scr, lane); continue; } r -= I1;
              if (r < I2) { const int kb = r / 32, nb = r % 32; tr_item(args.in[I_WHYO], 1024, 32 * nb + l31, WT_hyo, 512, 32 * nb, 64 * kb, scr, lane); continue; } r -= I2;
              if (r < I3) { const int kb = r / 32, nb = r % 32; tr_item(args.in[I_WOUT], 1024, 32 * nb + l31, WT_out, 1024, 32 * nb, 64 * kb, scr, lane); continue; } r -= I3;
              { const int kb = r / 32, nb = r % 32; tr_item(args.in[I_FW2], 1024, 32 * nb + l31, WT_2, FF, 32 * nb, 64 * kb, scr, lane); }
          } }
        LAS unsigned short* tile = (LAS unsigned short*)(lds + wave * 16384);
        for (int tl = gw; tl < 4096; tl += NGW) {
            const int c0 = 64 * (tl & 7), tok0 = 64 * (tl >> 3);
            u32x4 rr[8];
#pragma unroll
            for (int q = 0; q < 8; ++q) rr[q] = __builtin_nontemporal_load((const u32x4*)(YHT + (size_t)(c0 + 8 * q + (lane >> 3)) * MTOK + tok0 + 8 * (lane & 7)));
#pragma unroll
            for (int q = 0; q < 8; ++q) *(LAS u32x4*)(tile + (8 * q + (lane >> 3)) * 72 + 8 * (lane & 7)) = rr[q];
            LDS_WAIT(); asm volatile("" ::: "memory");
#pragma unroll
            for (int q = 0; q < 8; ++q) { const int tok = 8 * q + (lane >> 3); const LAS unsigned short* tp = tile + (8 * (lane & 7)) * 72 + tok;
                u32x4 w; w.x = (unsigned)tp[0] | ((unsigned)tp[72] << 16); w.y = (unsigned)tp[144] | ((unsigned)tp[216] << 16); w.z = (unsigned)tp[288] | ((unsigned)tp[360] << 16); w.w = (unsigned)tp[432] | ((unsigned)tp[504] << 16);
                *(u32x4*)(YHY + (size_t)(tok0 + tok) * 512 + c0 + 8 * (lane & 7)) = w; }
            LDS_WAIT(); asm volatile("" ::: "memory");
        }
    }
    SEAM(4);

    if (IN(5)) {
        pg8::Gemm g0{YNA, WT_nao, MTOK, 1024, 512}, g1{YHY, WT_hyo, MTOK, 1024, 512}; ep::DualOrder S; S.b.init(MTOK, 1024, G, bx); ep::EpiGateDual E{QKG, MB};
        pg8::gemm_phase_dual<ep::EpiGateDual, ep::DualOrder, true, true>(lds, g0, g1, S, E);
    }
    SEAM(5);

    if (IN(6)) {
        pg8::Gemm g{MB, WT_out, MTOK, 1024, 1024}; pg8::StaticOrder S; S.init(MTOK, 1024, G, bx); ep::EpiRes1 E{x, (bf16*)(ws + WS_Z1T), mod, args.in[I_N2G], H, rowss2};
        pg8::gemm_phase<ep::EpiRes1, pg8::StaticOrder, true, true>(lds, g, S, E);
    }
    SEAM(6);

    if (IN(7)) {
        pg8::Gemm g{H, WT_13, MTOK, 2 * FF, 1024}; pg8::StaticOrder S; S.init(MTOK, 2 * FF, G, bx); ep::EpiFFN E{HID, rowss2, sW};
        pg8::gemm_phase<ep::EpiFFN, pg8::StaticOrder, true, true>(lds, g, S, E);
    }
    SEAM(7);

    if (IN(8)) {
        pg8::Gemm g{HID, WT_2, MTOK, 1024, FF}; pg8::StaticOrder S; S.init(MTOK, 1024, G, bx); ep::EpiRes2 E{out, mod, rowss3, (const bf16*)(ws + WS_Z1T)};
        pg8::gemm_phase<ep::EpiRes2, pg8::StaticOrder, true, true>(lds, g, S, E);
    }
    SEAM(8);

    if (IN(9)) {
        const f32x4* fg = (const f32x4*)args.in[I_FING]; f32x4* o4 = (f32x4*)out;
        const int nth = G * NT; constexpr int TOT = MTOK * 256;
        for (int i = vcu * NT + tid; i < TOT; i += 4 * nth) {
            f32x4 v[4];
#pragma unroll
            for (int q = 0; q < 4; ++q) if (i + q * nth < TOT) v[q] = __builtin_nontemporal_load(o4 + i + q * nth);
#pragma unroll
            for (int q = 0; q < 4; ++q) { const int ii = i + q * nth; if (ii < TOT) { const float rstd = __builtin_amdgcn_rsqf((float)rowss3[ii >> 8] * (1.0f / (1024.0f * 1048576.0f)) + 1e-6f); __builtin_nontemporal_store(v[q] * rstd * fg[ii & 255], o4 + ii); } }
        }
    }
#undef IN
#undef SEAM
}

#ifndef MK_MULTI
#define MK_MULTI 0
#endif
extern "C" void kernel_launch(void* const* d_in, const int* in_sizes, int n_in, void* d_out, int out_size, void* d_ws, size_t ws_size, hipStream_t stream) {
    static int grid = 0;
    if (grid == 0) {
        if (n_in != 26 || out_size != MTOK * DM || ws_size < WS_END) { fprintf(stderr, "kernel_launch: unexpected shapes (n_in %d, out %d, ws %zu)\n", n_in, out_size, ws_size); grid = -1; return; }
        int dev = 0, cus = 0, per_cu = 0;
        (void)hipGetDevice(&dev); (void)hipDeviceGetAttribute(&cus, hipDeviceAttributeMultiprocessorCount, dev);
        if (hipFuncSetAttribute((const void*)mega_fwd, hipFuncAttributeMaxDynamicSharedMemorySize, LDS_BYTES) != hipSuccess) { fprintf(stderr, "kernel_launch: hipFuncSetAttribute failed\n"); grid = -1; return; }
        if (hipOccupancyMaxActiveBlocksPerMultiprocessor(&per_cu, (const void*)mega_fwd, NT, LDS_BYTES) != hipSuccess || per_cu < 1) { fprintf(stderr, "kernel_launch: occupancy query gave %d\n", per_cu); per_cu = 1; }
        (void)hipGetLastError();
        grid = cus * per_cu;
        fprintf(stderr, "kernel_launch: %d CUs x %d = grid %d\n", cus, per_cu, grid);
    }
    if (grid < 0) return;
    (void)hipMemsetAsync((unsigned char*)d_ws + WS_CTL, 0, CTL_BYTES, stream);
    Args a{};
    for (int i = 0; i < 26; ++i) a.in[i] = (const float*)d_in[i];
    a.out = (float*)d_out; a.ws = (unsigned char*)d_ws;
#if MK_MULTI
    for (int p = 0; p < NPHASE; ++p) { a.ph_lo = p; a.ph_hi = p + 1; hipLaunchKernelGGL(mega_fwd, dim3(grid), dim3(NT), LDS_BYTES, stream, a); }
#else
    a.ph_lo = 0; a.ph_hi = NPHASE;
    void* kargs[] = {&a};
    hipError_t e = hipLaunchCooperativeKernel((const void*)mega_fwd, dim3(grid), dim3(NT), kargs, LDS_BYTES, stream);
    if (e != hipSuccess) fprintf(stderr, "kernel_launch: cooperative launch failed: %s (grid %d)\n", hipGetErrorString(e), grid);
#endif
}
```
